# Optimizing an MI355X kernel written in HIP

```python
import jax
import jax.numpy as jnp
from jax import lax
import numpy as np

D_MODEL = 2048
BATCH = 8
SEQ = 2048
DEPTH = 2

GRID_W = 64
CTX_LEN = 256
EPS = 1e-6
NEG_INF = -1e30
ATT_HEADS = 16
ATT_KV_HEADS = 4
ATT_HEAD_DIM = 64
ATT_GROUP = ATT_HEADS // ATT_KV_HEADS
WINDOW = 128
ATT_BLOCK = 128
ROPE_THETA = 10000.0
ML_HEADS = 4
ML_DQK = 128
ML_DV = 256
ML_CHUNK = 128
GATE_SOFTCAP = 15.0
N_EXPERTS = 32
TOP_K = 4
D_FF = 1024
SWIGLU_LIMIT = 7.0
SWIGLU_ALPHA = 1.702
ATT_Q_W = ATT_HEADS * ATT_HEAD_DIM
ATT_KV_W = ATT_KV_HEADS * ATT_HEAD_DIM
ML_QK_W = ML_HEADS * ML_DQK
ML_V_W = ML_HEADS * ML_DV
N_GATES = 4 * ML_HEADS
PROJ_SIZES = (ATT_Q_W, ATT_KV_W, ATT_KV_W, ML_QK_W, ML_QK_W, ML_V_W, ML_V_W, N_GATES)
D_IN = sum(PROJ_SIZES)
D_CAT = ATT_Q_W + ML_V_W

kernel_name = 'hymba_swa_mlstm_moe_dit_prefix'


def _rmsnorm(x, w):
    xf = x.astype(jnp.float32)
    y = xf * lax.rsqrt(jnp.mean(xf * xf, axis=-1, keepdims=True) + EPS)
    return (y * w.astype(jnp.float32)).astype(x.dtype)


def _heads(t, n, d):
    return t.reshape(t.shape[:2] + (n, d))


def _split_proj(p):
    idx = np.cumsum(PROJ_SIZES)[:-1].tolist()
    return jnp.split(p, idx, axis=-1)


def _rope_tables(rows):
    row = jnp.repeat(jnp.arange(rows, dtype=jnp.float32), GRID_W)
    col = jnp.tile(jnp.arange(GRID_W, dtype=jnp.float32), rows)
    half = ATT_HEAD_DIM // 2
    inv_freq = ROPE_THETA ** (-jnp.arange(0, half, 2, dtype=jnp.float32) / half)

    def tab(p):
        ang = p[:, None] * inv_freq[None, :]
        ang = jnp.concatenate([ang, ang], axis=-1)
        return jnp.cos(ang)[:, None, :], jnp.sin(ang)[:, None, :]

    return tab(row), tab(col)


def _rot_half(x, cos, sin):
    x1, x2 = jnp.split(x, 2, axis=-1)
    return x * cos + jnp.concatenate([-x2, x1], axis=-1) * sin


def _rope_2d(x, tables):
    (cr, sr), (cc, sc) = tables
    xr, xc = jnp.split(x.astype(jnp.float32), 2, axis=-1)
    return jnp.concatenate([_rot_half(xr, cr, sr), _rot_half(xc, cc, sc)], axis=-1).astype(x.dtype)


def _latent_attention(q, k, v, kc, vc, sink):
    B, S = q.shape[:2]
    C = kc.shape[1]
    nb = S // ATT_BLOCK
    w3 = 3 * ATT_BLOCK
    qb = q.reshape(B, nb, ATT_BLOCK, ATT_KV_HEADS, ATT_GROUP, ATT_HEAD_DIM)

    def windows(t):
        tp = jnp.pad(t, ((0, 0), (WINDOW, WINDOW), (0, 0), (0, 0)))
        tp = tp.reshape(B, nb + 2, ATT_BLOCK, ATT_KV_HEADS, ATT_HEAD_DIM)
        return jnp.concatenate([tp[:, :-2], tp[:, 1:-1], tp[:, 2:]], axis=2)

    kw, vw = windows(k), windows(v)
    scale = ATT_HEAD_DIM ** -0.5
    s_loc = jnp.einsum('bnqkgd,bnwkd->bnkgqw', qb, kw).astype(jnp.float32) * scale
    r = jnp.arange(ATT_BLOCK)[:, None]
    w = jnp.arange(w3)[None, :]
    rel = w - r
    j = jnp.arange(nb)[:, None, None] * ATT_BLOCK - WINDOW + w[None]
    mask = (rel >= 0) & (rel <= 2 * WINDOW) & (j >= 0) & (j < S)
    s_loc = jnp.where(mask[None, :, None, None], s_loc, NEG_INF)
    s_ctx = jnp.einsum('bnqkgd,bckd->bnkgqc', qb, kc).astype(jnp.float32) * scale
    sink_b = jnp.broadcast_to(sink.astype(jnp.float32).reshape(1, 1, ATT_KV_HEADS, ATT_GROUP, 1, 1),
                              s_loc.shape[:-1] + (1,))
    p = jax.nn.softmax(jnp.concatenate([s_loc, s_ctx, sink_b], axis=-1), axis=-1)
    p_loc = p[..., :w3].astype(v.dtype)
    p_ctx = p[..., w3:w3 + C].astype(v.dtype)
    o = (jnp.einsum('bnkgqw,bnwkd->bnqkgd', p_loc, vw)
         + jnp.einsum('bnkgqc,bckd->bnqkgd', p_ctx, vc))
    return o.reshape(B, S, ATT_Q_W)


def _context_attention(qc, kc, vc, sink):
    B, C = qc.shape[:2]
    qg = qc.reshape(B, C, ATT_KV_HEADS, ATT_GROUP, ATT_HEAD_DIM)
    s = jnp.einsum('bqkgd,bckd->bkgqc', qg, kc).astype(jnp.float32) * ATT_HEAD_DIM ** -0.5
    sink_b = jnp.broadcast_to(sink.astype(jnp.float32).reshape(1, ATT_KV_HEADS, ATT_GROUP, 1, 1),
                              s.shape[:-1] + (1,))
    p = jax.nn.softmax(jnp.concatenate([s, sink_b], axis=-1), axis=-1)[..., :C].astype(vc.dtype)
    return jnp.einsum('bkgqc,bckd->bqkgd', p, vc).reshape(B, C, ATT_Q_W)


def _mlstm_scan(q, k, v, i_pre, f_pre, state):
    B, T, H = q.shape[:3]
    nc = T // ML_CHUNK

    def chunks(t):
        t = t.reshape((B, nc, ML_CHUNK) + t.shape[2:])
        return jnp.moveaxis(jnp.swapaxes(t, 2, 3), 1, 0)

    tril = jnp.tril(jnp.ones((ML_CHUNK, ML_CHUNK), dtype=bool))

    def step(carry, xs):
        Cm, n, m = carry
        qc, kc, vc, ic, fc = xs
        b = jnp.cumsum(jax.nn.log_sigmoid(fc), axis=-1)
        dmat = jnp.where(tril, b[..., :, None] - b[..., None, :] + ic[..., None, :], NEG_INF)
        inter = b + m[..., None]
        m_t = jnp.maximum(inter, jnp.max(dmat, axis=-1))
        w_intra = jnp.einsum('bhtd,bhsd->bhts', qc, kc) * jnp.exp(dmat - m_t[..., None])
        w_inter = jnp.exp(inter - m_t)
        num = (jnp.einsum('bhts,bhsv->bhtv', w_intra, vc)
               + w_inter[..., None] * jnp.einsum('bhvd,bhtd->bhtv', Cm, qc))
        den = jnp.sum(w_intra, axis=-1) + w_inter * jnp.einsum('bhd,bhtd->bht', n, qc)
        h = num / jnp.maximum(jnp.abs(den), jnp.exp(-m_t))[..., None]
        b_last = b[..., -1]
        g = b_last[..., None] - b + ic
        m_new = jnp.maximum(b_last + m, jnp.max(g, axis=-1))
        w_s = jnp.exp(g - m_new[..., None])
        w_c = jnp.exp(b_last + m - m_new)
        C_new = w_c[..., None, None] * Cm + jnp.einsum('bhs,bhsv,bhsd->bhvd', w_s, vc, kc)
        n_new = w_c[..., None] * n + jnp.einsum('bhs,bhsd->bhd', w_s, kc)
        return (C_new, n_new, m_new), h

    state, h = lax.scan(step, state, (chunks(q), chunks(k), chunks(v), chunks(i_pre), chunks(f_pre)))
    h = jnp.swapaxes(jnp.moveaxis(h, 0, 1), 2, 3).reshape(B, T, H, ML_DV)
    return h, state


def _flip(t):
    return jnp.flip(t, axis=1)


def _mlstm_bwd(q, k, v, i_pre, f_pre, state):
    h, st = _mlstm_scan(_flip(q), _flip(k), _flip(v), _flip(i_pre), _flip(f_pre), state)
    return _flip(h), st


def _mlstm_inputs(mq, mk, mv, g, b_gates):
    q = _heads(mq, ML_HEADS, ML_DQK).astype(jnp.float32)
    k = _heads(mk, ML_HEADS, ML_DQK).astype(jnp.float32) * ML_DQK ** -0.5
    v = _heads(mv, ML_HEADS, ML_DV).astype(jnp.float32)
    g = g.astype(jnp.float32) + b_gates.astype(jnp.float32)
    g = GATE_SOFTCAP * jnp.tanh(g / GATE_SOFTCAP)
    i_f, f_f, i_b, f_b = jnp.split(g, 4, axis=-1)
    return q, k, v, i_f, f_f, i_b, f_b


def _mlstm_out(h_f, h_b, o_pre, norm_w, dtype):
    B, T = h_f.shape[:2]
    h = _rmsnorm(h_f + h_b, norm_w.reshape(ML_HEADS, ML_DV)).reshape(B, T, ML_V_W).astype(dtype)
    return h * jax.nn.sigmoid(o_pre)


def _moe(h, w_router, b_router, w_gate_up, b_gate_up, w_down, b_down):
    logits = (h @ w_router).astype(jnp.float32) + b_router.astype(jnp.float32)
    top_v, top_i = lax.top_k(logits, TOP_K)
    top_w = jax.nn.softmax(top_v, axis=-1)
    combine = jnp.sum(jax.nn.one_hot(top_i, N_EXPERTS, dtype=jnp.float32) * top_w[..., None], axis=1)
    out = jnp.zeros(h.shape, jnp.float32)
    for e in range(N_EXPERTS):
        gate, up = jnp.split(h @ w_gate_up[e] + b_gate_up[e], 2, axis=-1)
        gate = jnp.minimum(gate, SWIGLU_LIMIT)
        up = jnp.clip(up, -SWIGLU_LIMIT, SWIGLU_LIMIT)
        y = ((up + 1) * gate * jax.nn.sigmoid(SWIGLU_ALPHA * gate)) @ w_down[e] + b_down[e]
        out = out + combine[:, e:e + 1] * y
    return out.astype(h.dtype)


def _layer(x, ctx, mod_x, mod_c, norm1_w, norm2_w, w_in, b_gates, q_norm_w, k_norm_w, attn_sink,
           mlstm_norm_w, w_out, w_router, b_router, w_gate_up, b_gate_up, w_down, b_down, rope, update_ctx):
    B, S, D = x.shape
    C = ctx.shape[1]
    sh1, sc1, g1, sh2, sc2, g2 = jnp.split(mod_x, 6, axis=-1)
    csh1, csc1, cg1, csh2, csc2, cg2 = jnp.split(mod_c, 6, axis=-1)

    hx = _rmsnorm(x, norm1_w) * (1 + sc1[:, None]) + sh1[:, None]
    hc = _rmsnorm(ctx, norm1_w) * (1 + csc1) + csh1
    qx, kx, vx, mqx, mkx, mvx, mox, gx = _split_proj(hx @ w_in)
    qc, kc, vc, mqc, mkc, mvc, moc, gc = _split_proj(hc @ w_in)

    qx = _rope_2d(_rmsnorm(_heads(qx, ATT_HEADS, ATT_HEAD_DIM), q_norm_w), rope)
    kx = _rope_2d(_rmsnorm(_heads(kx, ATT_KV_HEADS, ATT_HEAD_DIM), k_norm_w), rope)
    vx = _heads(vx, ATT_KV_HEADS, ATT_HEAD_DIM)
    qc = _rmsnorm(_heads(qc, ATT_HEADS, ATT_HEAD_DIM), q_norm_w)
    kc = _rmsnorm(_heads(kc, ATT_KV_HEADS, ATT_HEAD_DIM), k_norm_w)
    vc = _heads(vc, ATT_KV_HEADS, ATT_HEAD_DIM)
    att_x = _latent_attention(qx, kx, vx, kc, vc, attn_sink)

    cq, ck, cv, ci_f, cf_f, ci_b, cf_b = _mlstm_inputs(mqc, mkc, mvc, gc, b_gates)
    lq, lk, lv, li_f, lf_f, li_b, lf_b = _mlstm_inputs(mqx, mkx, mvx, gx, b_gates)
    zero_state = (jnp.zeros((B, ML_HEADS, ML_DV, ML_DQK), jnp.float32),
                  jnp.zeros((B, ML_HEADS, ML_DQK), jnp.float32),
                  jnp.zeros((B, ML_HEADS), jnp.float32))
    hc_f, st_f = _mlstm_scan(cq, ck, cv, ci_f, cf_f, zero_state)
    hc_b, st_b = _mlstm_bwd(cq, ck, cv, ci_b, cf_b, zero_state)
    hx_f, _ = _mlstm_scan(lq, lk, lv, li_f, lf_f, st_f)
    hx_b, _ = _mlstm_bwd(lq, lk, lv, li_b, lf_b, st_b)
    ml_x = _mlstm_out(hx_f, hx_b, mox, mlstm_norm_w, x.dtype)

    x = x + g1[:, None] * (jnp.concatenate([att_x, ml_x], axis=-1) @ w_out)
    if update_ctx:
        att_c = _context_attention(qc, kc, vc, attn_sink)
        ml_c = _mlstm_out(hc_f, hc_b, moc, mlstm_norm_w, ctx.dtype)
        ctx = ctx + cg1 * (jnp.concatenate([att_c, ml_c], axis=-1) @ w_out)

    fx = (_rmsnorm(x, norm2_w) * (1 + sc2[:, None]) + sh2[:, None]).reshape(B * S, D)
    if update_ctx:
        fc = (_rmsnorm(ctx, norm2_w) * (1 + csc2) + csh2).reshape(B * C, D)
        y = _moe(jnp.concatenate([fx, fc], axis=0), w_router, b_router, w_gate_up, b_gate_up, w_down, b_down)
        x = x + g2[:, None] * y[:B * S].reshape(B, S, D)
        ctx = ctx + cg2 * y[B * S:].reshape(B, C, D)
    else:
        y = _moe(fx, w_router, b_router, w_gate_up, b_gate_up, w_down, b_down)
        x = x + g2[:, None] * y.reshape(B, S, D)
    return x, ctx


def setup_inputs(seed: int = 0) -> dict:
    key = jax.random.key(seed)
    ks = jax.random.split(key, 24)
    L, D, E, F = DEPTH, D_MODEL, N_EXPERTS, D_FF
    nrm = jax.random.normal
    f_bias = jnp.broadcast_to(jnp.linspace(3.0, 6.0, ML_HEADS, dtype=jnp.float32), (L, ML_HEADS))
    gate_noise = 0.1 * nrm(ks[4], (L, N_GATES), jnp.float32)
    b_gates = gate_noise + jnp.concatenate([jnp.zeros((L, ML_HEADS)), f_bias, jnp.zeros((L, ML_HEADS)), f_bias], axis=-1)
    return {
        'x': nrm(ks[0], (BATCH, SEQ, D), jnp.float32),
        'c': nrm(ks[1], (BATCH, D), jnp.float32),
        'ctx': nrm(ks[2], (BATCH, CTX_LEN, D), jnp.float32),
        'c_ctx': nrm(ks[3], (D,), jnp.float32),
        'w_ada': 0.5 * D ** -0.5 * nrm(ks[5], (L, D, 6 * D), jnp.float32),
        'b_ada': 0.01 * nrm(ks[6], (L, 6 * D), jnp.float32),
        'norm1_w': 1.0 + 0.1 * nrm(ks[7], (L, D), jnp.float32),
        'norm2_w': 1.0 + 0.1 * nrm(ks[8], (L, D), jnp.float32),
        'w_in': D ** -0.5 * nrm(ks[9], (L, D, D_IN), jnp.float32),
        'b_gates': b_gates,
        'q_norm_w': 1.0 + 0.1 * nrm(ks[10], (L, ATT_HEAD_DIM), jnp.float32),
        'k_norm_w': 1.0 + 0.1 * nrm(ks[11], (L, ATT_HEAD_DIM), jnp.float32),
        'attn_sink': 0.5 * nrm(ks[12], (L, ATT_HEADS), jnp.float32),
        'mlstm_norm_w': 1.0 + 0.1 * nrm(ks[13], (L, ML_V_W), jnp.float32),
        'w_out': D_CAT ** -0.5 * nrm(ks[14], (L, D_CAT, D), jnp.float32),
        'w_router': D ** -0.5 * nrm(ks[15], (L, D, E), jnp.float32),
        'b_router': 0.01 * nrm(ks[16], (L, E), jnp.float32),
        'w_gate_up': D ** -0.5 * nrm(ks[17], (L, E, D, 2 * F), jnp.float32),
        'b_gate_up': 0.01 * nrm(ks[18], (L, E, 2 * F), jnp.float32),
        'w_down': F ** -0.5 * nrm(ks[19], (L, E, F, D), jnp.float32),
        'b_down': 0.01 * nrm(ks[20], (L, E, D), jnp.float32),
    }


def reference(x, c, ctx, c_ctx, w_ada, b_ada, norm1_w, norm2_w, w_in, b_gates, q_norm_w, k_norm_w,
              attn_sink, mlstm_norm_w, w_out, w_router, b_router, w_gate_up, b_gate_up, w_down, b_down):
    ROWS = x.shape[1] // GRID_W
    rope = _rope_tables(ROWS)
    silu_c = jax.nn.silu(c)
    silu_cc = jax.nn.silu(c_ctx)
    for l in range(DEPTH):
        mod_x = silu_c @ w_ada[l] + b_ada[l]
        mod_c = silu_cc @ w_ada[l] + b_ada[l]
        x, ctx = _layer(x, ctx, mod_x, mod_c, norm1_w[l], norm2_w[l], w_in[l], b_gates[l], q_norm_w[l],
                        k_norm_w[l], attn_sink[l], mlstm_norm_w[l], w_out[l], w_router[l], b_router[l],
                        w_gate_up[l], b_gate_up[l], w_down[l], b_down[l], rope, l < DEPTH - 1)
    return x
```

```cpp
#include <hip/hip_runtime.h>
#include <cstdio>
#include <cstdint>

#ifndef DUP_MASK
#define DUP_MASK 0u
#endif
#ifndef DUP_ATT
#define DUP_ATT 0
#endif
#ifndef DUP_ML
#define DUP_ML 0
#endif
#ifndef MK_ONE_LAUNCH
#define MK_ONE_LAUNCH 1
#endif

#define LAS __attribute__((address_space(3)))
#define GAS __attribute__((address_space(1)))
typedef unsigned short bf16;
typedef short bf16x8 __attribute__((ext_vector_type(8)));
typedef short bf16x4 __attribute__((ext_vector_type(4)));
typedef float f32x4 __attribute__((ext_vector_type(4)));
typedef float f32x2 __attribute__((ext_vector_type(2)));
typedef unsigned u32x4 __attribute__((ext_vector_type(4)));
typedef unsigned u32x2 __attribute__((ext_vector_type(2)));
typedef int i32x4 __attribute__((ext_vector_type(4)));

constexpr int NB = 8, SEQ = 2048, DM = 2048, CTXL = 256, DEPTH = 2;
constexpr int TL = NB * SEQ, TC = NB * CTXL, TT = TL + TC;
constexpr int DIN = 4624, DINM = 4608, NEXP = 32, DFF = 1024, MODW = 6 * DM;
constexpr int MAXPANEL = 320, MAXSLOT = MAXPANEL * 256;
constexpr float EPS = 1e-6f;
constexpr float LOG2E = 1.4426950408889634f;

constexpr size_t MiB = 1u << 20;
constexpr size_t WS_CTL = 0, CTL_BYTES = 1 * MiB;
constexpr size_t WS_ROPE = 1 * MiB;
constexpr size_t WS_WGP = 2 * MiB;
constexpr size_t WS_WRP = 3 * MiB;
constexpr size_t WS_MOD = 4 * MiB;
constexpr size_t WS_GATES = 5 * MiB;
constexpr size_t WS_TOKE = 7 * MiB;
constexpr size_t WS_TOKP = 8 * MiB;
constexpr size_t WS_IDXL = 9 * MiB;
constexpr size_t WS_WL = 12 * MiB;
constexpr size_t WS_WIN = 16 * MiB;
constexpr size_t WS_WOUT = 52 * MiB;
constexpr size_t WS_WGU = 68 * MiB;
constexpr size_t WS_WD = 580 * MiB;
constexpr size_t WS_HX = 836 * MiB;
constexpr size_t WS_PR = 908 * MiB;
constexpr size_t WS_HF = 1070 * MiB;
constexpr size_t WS_HB = 1106 * MiB;
constexpr size_t WS_CAT = 1142 * MiB;
constexpr size_t WS_XB = 1214 * MiB;
constexpr size_t WS_XA = 1358 * MiB;
constexpr size_t WS_H = 1502 * MiB;
constexpr size_t WS_Y = 1662 * MiB;
constexpr size_t WS_GS = 1982 * MiB;
constexpr size_t WS_END = 1990 * MiB;
constexpr int CW_CNT = 64;
constexpr int CW_BAR = 4096;
constexpr int CW_CQ = 256;
constexpr int CW_TD = 320;

constexpr int LDS_BYTES = 163840;
constexpr int TBL_OFF = 161280;
constexpr int EC_OFF = 131072;
constexpr int EC_MAXU = 14;
constexpr int BARW_OFF = LDS_BYTES - 64;

struct Args {
    const float *x, *c, *ctx, *c_ctx, *w_ada, *b_ada, *norm1_w, *norm2_w, *w_in, *b_gates, *q_norm_w, *k_norm_w, *attn_sink, *mlstm_norm_w,
                *w_out, *w_router, *b_router, *w_gate_up, *b_gate_up, *w_down, *b_down;
    float* out; unsigned char* ws; int ph_lo, ph_hi;
};

enum { SLOT_x = 0, SLOT_c = 1, SLOT_ctx = 2, SLOT_c_ctx = 3, SLOT_w_ada = 4, SLOT_b_ada = 5, SLOT_norm1_w = 6, SLOT_norm2_w = 7, SLOT_w_in = 8, SLOT_b_gates = 9, SLOT_q_norm_w = 10, SLOT_k_norm_w = 11, SLOT_attn_sink = 12, SLOT_mlstm_norm_w = 13, SLOT_w_out = 14, SLOT_w_router = 15, SLOT_b_router = 16, SLOT_w_gate_up = 17, SLOT_b_gate_up = 18, SLOT_w_down = 19, SLOT_b_down = 20, SLOT_out = 21, SLOT_ws = 22 };
constexpr int PTAB_OFF = LDS_BYTES - 512;
template <class T> __device__ __forceinline__ T* ldp(LAS unsigned char* lds, int slot) {
    const unsigned long long v = *(const LAS unsigned long long*)(lds + PTAB_OFF + 8 * slot);
    const unsigned lo = __builtin_amdgcn_readfirstlane((unsigned)v), hi = __builtin_amdgcn_readfirstlane((unsigned)(v >> 32));
    return (T*)(GAS T*)(((unsigned long long)hi << 32) | lo);
}
#define AP(f) ldp<const float>(lds, SLOT_##f)

__device__ __forceinline__ unsigned f2bf(float f) { unsigned u = __float_as_uint(f); return (u + 0x7fffu + ((u >> 16) & 1u)) >> 16; }
__device__ __forceinline__ unsigned pk2(float lo, float hi) { return f2bf(lo) | (f2bf(hi) << 16); }
__device__ __forceinline__ float bf2f(unsigned b) { return __uint_as_float(b << 16); }
__device__ __forceinline__ float bflo(unsigned w) { return __uint_as_float(w << 16); }
__device__ __forceinline__ float bfhi(unsigned w) { return __uint_as_float(w & 0xffff0000u); }
__device__ __forceinline__ unsigned cvt_pk_bf16(float lo, float hi) { unsigned r; asm volatile("v_cvt_pk_bf16_f32 %0, %1, %2" : "=v"(r) : "v"(lo), "v"(hi)); return r; }
__device__ __forceinline__ float sigmoidf_(float z) { return __builtin_amdgcn_rcpf(1.0f + __expf(-z)); }
__device__ __forceinline__ int otid(int wv) { int l; asm volatile("v_mbcnt_lo_u32_b32 %0, -1, 0\n\tv_mbcnt_hi_u32_b32 %0, -1, %0" : "=v"(l)); return (wv << 6) | l; }
__device__ __forceinline__ float shx(float v, int m, int lane) { return __int_as_float(__builtin_amdgcn_ds_bpermute((lane ^ m) << 2, __float_as_int(v))); }
__device__ __forceinline__ float shup(float v, int off, int lane) { return __int_as_float(__builtin_amdgcn_ds_bpermute(((lane - off) & 63) << 2, __float_as_int(v))); }
__device__ __forceinline__ int opqi(int v) { asm volatile("" : "+s"(v)); return v; }
__device__ __forceinline__ unsigned char* opq(unsigned char* p) { unsigned z = 0; asm volatile("" : "+s"(z)); return p + z; }
__device__ __forceinline__ f32x4 zero4() {
    float a, b, c, d; asm volatile("v_mov_b32 %0, 0\n\tv_mov_b32 %1, 0\n\tv_mov_b32 %2, 0\n\tv_mov_b32 %3, 0" : "=v"(a), "=v"(b), "=v"(c), "=v"(d)); return (f32x4){a, b, c, d}; }
__device__ __forceinline__ unsigned pk4_fp8(float a, float b, float c, float d) { int w = __builtin_amdgcn_cvt_pk_fp8_f32(a, b, 0, false); w = __builtin_amdgcn_cvt_pk_fp8_f32(c, d, w, true); return (unsigned)w; }
__device__ __forceinline__ float clamp8(float v) { return fminf(fmaxf(v, -448.0f), 448.0f); }
__device__ __forceinline__ f32x4 up4_fp8(unsigned w) { const f32x2 a = __builtin_amdgcn_cvt_pk_f32_fp8((int)w, false), b = __builtin_amdgcn_cvt_pk_f32_fp8((int)w, true); return (f32x4){a[0], a[1], b[0], b[1]}; }
constexpr float Y8S = 16.0f, Y8I = 0.0625f;
constexpr float C8S = 16.0f, C8I = 0.0625f;
constexpr float W8S = 32.0f, W8I = 0.03125f;
#define LDS_WAIT() asm volatile("s_waitcnt lgkmcnt(0)" ::: "memory")
#define VM_WAIT() asm volatile("s_waitcnt vmcnt(0)" ::: "memory")

namespace gm {
constexpr int BM = 256, BK = 64, HALF = 128, HTB = HALF * BK * 2, STAGE_BYTES = 8 * HTB, NXCD = 8, WGM = 8;
__host__ __device__ __forceinline__ int lds_byte(int r, int c) { const int st = (r >> 4) * 2 + (c >> 5), rr = r & 15, cc = c & 31, ob = rr * 64 + cc * 2; return st * 1024 + (ob ^ (((ob >> 9) & 1) << 5)); }
__host__ __device__ __forceinline__ void stage_rc(int b, int& R, int& C) { const int st = b / 1024, sb = b % 1024, swz = sb ^ (((sb >> 9) & 1) << 5); R = (st >> 1) * 16 + swz / 64; C = (st & 1) * 32 + (swz % 64) / 2; }
__host__ __device__ __forceinline__ int perm32(int rho) { const int n = rho >> 4, i = rho & 15; return 8 * (i >> 2) + 4 * n + (i & 3); }
struct Unit { int pm, pn; };
typedef int v8i_t __attribute__((ext_vector_type(8)));
__device__ __forceinline__ v8i_t cat8i(bf16x8 a, bf16x8 b) { const u32x4 x = __builtin_bit_cast(u32x4, a), y = __builtin_bit_cast(u32x4, b); v8i_t r; r[0] = (int)x.x; r[1] = (int)x.y; r[2] = (int)x.z; r[3] = (int)x.w; r[4] = (int)y.x; r[5] = (int)y.y; r[6] = (int)y.z; r[7] = (int)y.w; return r; }
struct InProjOrder {
    int G, c, full;
    __device__ void init(int G_, int c_, int full_) { G = G_; c = c_; full = full_; }
    __device__ bool next(int i, Unit& u) const {
        const int nlat = 64 * 18, nwg = full ? 72 * 18 : nlat + 8 * 8;
        const long L = (long)i * G + c; if (L >= nwg) return false;
        int wgid = (int)L;
        if (!full && wgid >= nlat) { const int r = wgid - nlat, t = r & 7; u.pm = 64 + (r >> 3); u.pn = t < 2 ? 4 + t : 6 + t; return true; }
        const int nM = full ? 72 : 64, nN = 18, nw2 = nM * nN;
        { const int q = nw2 / NXCD, r = nw2 % NXCD, xcd = wgid % NXCD, off = wgid / NXCD; wgid = (xcd < r ? xcd * (q + 1) : r * (q + 1) + (xcd - r) * q) + off; }
        const int nig = WGM * nN, gid = wgid / nig, fm = gid * WGM, gsz = (nM - fm) < WGM ? (nM - fm) : WGM;
        u.pm = fm + ((wgid % nig) % gsz); u.pn = (wgid % nig) / gsz; return true;
    }
};
struct StaticOrder {
    int nM, nN, nwg, G, c;
    __device__ void init(int nM_, int nN_, int G_, int c_) { nM = nM_; nN = nN_; nwg = nM * nN; G = G_; c = c_; }
    __device__ bool next(int i, Unit& u) const {
        const long L = (long)i * G + c; if (L >= nwg) return false;
        int wgid = (int)L; { const int q = nwg / NXCD, r = nwg % NXCD, xcd = wgid % NXCD, off = wgid / NXCD; wgid = (xcd < r ? xcd * (q + 1) : r * (q + 1) + (xcd - r) * q) + off; }
        const int nig = WGM * nN, gid = wgid / nig, fm = gid * WGM, gsz = (nM - fm) < WGM ? (nM - fm) : WGM;
        u.pm = fm + ((wgid % nig) % gsz); u.pn = (wgid % nig) / gsz; return true;
    }
};

template <class Src, class Epi, class Sched>
__device__ __forceinline__ void gemm_phase(LAS unsigned char* lds, int wv_, const Src& G, const Sched& S, const Epi& E) {
    const int tid = otid(wv_), wid = __builtin_amdgcn_readfirstlane(tid >> 6), lane = tid & 63, wr = wid >> 2, wc = wid & 3, fr = lane & 15, fq = lane >> 4;
    constexpr bool FP8 = Src::FP8;
    const int KB = FP8 ? G.K : G.K * 2, nt = KB / 128;
    unsigned voffB[2];
#pragma unroll
    for (int i = 0; i < 2; ++i) { int R, C; stage_rc(tid * 16 + i * 8192, R, C); voffB[i] = (unsigned)(R * KB + 2 * C); }
    const size_t hstepB = (size_t)HALF * KB;
    const size_t hstepA = Src::GATHER ? 0 : hstepB;
    const unsigned ldsw = (unsigned)wid * 1024u;
    const int aoff = lds_byte(wr * 64 + fr, fq * 8), boff = lds_byte(wc * 32 + fr, fq * 8);
    constexpr int FD = 1024;
#define PG8_SA(b, h) (((b) * 2 + (h)) * HTB)
#define PG8_SB(b, h) ((4 + (b) * 2 + (h)) * HTB)
#define PG8_STAGE_B(bufoff, gbase) do { _Pragma("unroll") for (int _i = 0; _i < 2; ++_i) \
        __builtin_amdgcn_global_load_lds((const unsigned*)((const char*)(gbase) + voffB[_i]), (LAS unsigned*)(lds + (bufoff) + ldsw + _i * 8192), 16, 0, 0); } while (0)
#define PG8_STAGE_A(bufoff, h, kbyte) do { const char* _ap = Ab + (size_t)(kbyte) + (size_t)(h) * hstepA; _Pragma("unroll") for (int _i = 0; _i < 2; ++_i) \
        __builtin_amdgcn_global_load_lds((const unsigned*)(_ap + va[Src::GATHER ? (h) : 0][_i]), (LAS unsigned*)(lds + (bufoff) + ldsw + _i * 8192), 16, 0, 0); } while (0)
#define PG8_LDA(dst, b, h) do { _Pragma("unroll") for (int m = 0; m < 4; ++m) _Pragma("unroll") for (int k = 0; k < 2; ++k) dst[m][k] = *(const LAS bf16x8*)(lds + PG8_SA(b, h) + aoff + m * 2048 + k * FD); } while (0)
#define PG8_LDB(dst, b, h) do { _Pragma("unroll") for (int n = 0; n < 2; ++n) _Pragma("unroll") for (int k = 0; k < 2; ++k) dst[n][k] = *(const LAS bf16x8*)(lds + PG8_SB(b, h) + boff + n * 2048 + k * FD); } while (0)
#define PG8_MMA(ai, bj, At, Bt) do { __builtin_amdgcn_s_setprio(1); _Pragma("unroll") for (int m = 0; m < 4; ++m) _Pragma("unroll") for (int n = 0; n < 2; ++n) { \
        if constexpr (FP8) acc[ai][bj][m][n] = __builtin_amdgcn_mfma_scale_f32_16x16x128_f8f6f4(cat8i(Bt[n][0], Bt[n][1]), cat8i(At[m][0], At[m][1]), acc[ai][bj][m][n], 0, 0, 0, 0x7f7f7f7f, 0, 0x7f7f7f7f); \
        else { _Pragma("unroll") for (int k = 0; k < 2; ++k) acc[ai][bj][m][n] = __builtin_amdgcn_mfma_f32_16x16x32_bf16(Bt[n][k], At[m][k], acc[ai][bj][m][n], 0, 0, 0); } } \
        __builtin_amdgcn_s_setprio(0); } while (0)
#define PG8_WAIT_V(n) asm volatile("s_waitcnt vmcnt(" #n ")" ::: "memory")
#define PG8_WAIT_L(n) asm volatile("s_waitcnt lgkmcnt(" #n ")" ::: "memory")
#define PG8_BAR __builtin_amdgcn_s_barrier()
#define PG8_SCHED __builtin_amdgcn_sched_barrier(0)
    Unit cur, nxt; int ui = 0;
    if (!S.next(0, cur)) return;
    f32x4 acc[2][2][4][2];
    const f32x4 zq = zero4();
#pragma unroll
    for (int a = 0; a < 2; ++a)
#pragma unroll
        for (int b = 0; b < 2; ++b)
#pragma unroll
            for (int m = 0; m < 4; ++m)
#pragma unroll
                for (int n = 0; n < 2; ++n) acc[a][b][m][n] = zq;
    bf16x8 At[4][2], B0[2][2], B1[2][2];
    unsigned va[Src::GATHER ? 2 : 1][2];
    G.aoff(cur, tid, va, 0);
    const char* const Ab = G.abase();
    const char* cB = G.bptr(cur);
    const unsigned kstep = BK * 2;
    PG8_STAGE_B(PG8_SB(0, 0), cB); PG8_STAGE_B(PG8_SB(0, 1), cB + hstepB); PG8_STAGE_A(PG8_SA(0, 0), 0, 0u); PG8_STAGE_A(PG8_SA(0, 1), 1, 0u);
    if (wr == 1) PG8_BAR;
    PG8_WAIT_V(2); PG8_BAR;
    PG8_STAGE_B(PG8_SB(1, 0), cB + kstep); PG8_STAGE_A(PG8_SA(1, 0), 0, kstep); PG8_STAGE_B(PG8_SB(1, 1), cB + hstepB + kstep);
    PG8_WAIT_V(6); PG8_BAR;
    for (;;) {
        const bool has_next = S.next(ui + 1, nxt);
        const char* nB = cB;
        for (int t = 0; t < nt; t += 2) {
            const bool last = (t == nt - 2);
            PG8_STAGE_A(PG8_SA(1, 1), 1, (unsigned)(t + 1) * kstep); PG8_SCHED; PG8_LDB(B0, 0, 0); PG8_LDB(B1, 0, 1); PG8_SCHED; PG8_LDA(At, 0, 0);
            PG8_WAIT_V(8); PG8_WAIT_L(0); PG8_BAR; PG8_MMA(0, 0, At, B0); PG8_MMA(0, 1, At, B1); PG8_BAR; PG8_SCHED;
            const char* b2; unsigned k2;
            if (last) { if (has_next) { G.aoff(nxt, tid, va, ui + 1); nB = G.bptr(nxt); } b2 = nB; k2 = 0u; }
            else { b2 = cB + (size_t)(t + 2) * kstep; k2 = (unsigned)(t + 2) * kstep; }
            PG8_STAGE_B(PG8_SB(0, 0), b2); PG8_STAGE_B(PG8_SB(0, 1), b2 + hstepB); PG8_STAGE_A(PG8_SA(0, 0), 0, k2); PG8_SCHED; PG8_LDA(At, 0, 1);
            PG8_WAIT_V(8); PG8_WAIT_L(0); PG8_BAR; PG8_MMA(1, 0, At, B0); PG8_MMA(1, 1, At, B1); PG8_BAR; PG8_SCHED;
            PG8_STAGE_A(PG8_SA(0, 1), 1, k2); PG8_SCHED; PG8_LDB(B0, 1, 0); PG8_LDB(B1, 1, 1); PG8_SCHED; PG8_LDA(At, 1, 0);
            PG8_WAIT_V(8); PG8_WAIT_L(0); PG8_BAR; PG8_MMA(0, 0, At, B0); PG8_MMA(0, 1, At, B1); PG8_BAR; PG8_SCHED;
            PG8_STAGE_B(PG8_SB(1, 0), b2 + kstep); PG8_STAGE_B(PG8_SB(1, 1), b2 + hstepB + kstep); PG8_STAGE_A(PG8_SA(1, 0), 0, k2 + kstep); PG8_SCHED; PG8_LDA(At, 1, 1);
            PG8_WAIT_V(8); PG8_WAIT_L(0); PG8_BAR; PG8_MMA(1, 0, At, B0); PG8_MMA(1, 1, At, B1); PG8_BAR; PG8_SCHED;
        }
        if (wr == 0) PG8_BAR;
        E(acc, cur, wr, wc, fr, fq, ui);
        if (!has_next) break;
        const f32x4 zq2 = zero4();
#pragma unroll
        for (int a = 0; a < 2; ++a)
#pragma unroll
            for (int b = 0; b < 2; ++b)
#pragma unroll
                for (int m = 0; m < 4; ++m)
#pragma unroll
                    for (int n = 0; n < 2; ++n) acc[a][b][m][n] = zq2;
        cur = nxt; cB = nB; ++ui;
        if (wr == 1) PG8_BAR;
    }
    PG8_WAIT_V(0);
    PG8_BAR;
#undef PG8_SA
#undef PG8_SB
#undef PG8_STAGE_A
#undef PG8_STAGE_B
#undef PG8_LDA
#undef PG8_LDB
#undef PG8_MMA
#undef PG8_WAIT_V
#undef PG8_WAIT_L
#undef PG8_BAR
#undef PG8_SCHED
}
}

struct ETab { const LAS int* pe; const LAS int* pbase; const LAS int* cnt; };
__device__ __forceinline__ ETab build_etab(LAS unsigned char* lds, int wv_, const unsigned* gcnt) {
    LAS int* pe = (LAS int*)(lds + TBL_OFF); LAS int* pbase = pe + 384; LAS int* cnt = pbase + 40;
    const int tid = otid(wv_);
    __syncthreads();
    if (tid < 32) cnt[tid] = (int)gcnt[tid];
    __syncthreads();
    if (tid == 0) { int p = 0;
#pragma clang loop unroll(disable) vectorize(disable)
        for (int e = 0; e < NEXP; ++e) { pbase[e] = p; p += (cnt[e] + 255) >> 8; }
        pbase[NEXP] = p; }
    __syncthreads();
    if (tid < 384) { int e = 0;
#pragma clang loop unroll(disable) vectorize(disable)
        for (int j = 1; j <= NEXP; ++j) e += (pbase[j] <= tid) ? 1 : 0;
        pe[tid] = e < NEXP ? e : NEXP - 1; }
    __syncthreads();
    ETab t; t.pe = pe; t.pbase = pbase; t.cnt = cnt; return t;
}

template <class Sched, class F>
__device__ __forceinline__ void ec_preload(int wv_, const Sched& S, F&& fill) {
    const int tid = otid(wv_);
    __syncthreads();
    gm::Unit u;
    for (int i = 0; i < EC_MAXU && S.next(i, u); ++i) fill(i, u, tid);
    __syncthreads();
}
struct SrcDense {
    const char* A; const char* Bt; int K;
    __device__ __forceinline__ const char* abase() const { return A; }
    __device__ __forceinline__ const char* bptr(const gm::Unit& u) const { return Bt + (size_t)u.pn * 256 * K * 2; }
    static constexpr bool GATHER = false, FP8 = false;
    __device__ __forceinline__ void aoff(const gm::Unit& u, int tid, unsigned (&va)[1][2], int) const {
        asm volatile("" : "+v"(tid));
#pragma unroll
        for (int i = 0; i < 2; ++i) { int R, C; gm::stage_rc(tid * 16 + i * 8192, R, C); va[0][i] = (unsigned)((u.pm * 256 + R) * K + C) * 2u; }
    }
};
struct SrcDense8 {
    const char* A; const char* Bt; int K;
    __device__ __forceinline__ const char* abase() const { return A; }
    __device__ __forceinline__ const char* bptr(const gm::Unit& u) const { return Bt + (size_t)u.pn * 256 * K; }
    static constexpr bool GATHER = false, FP8 = true;
    __device__ __forceinline__ void aoff(const gm::Unit& u, int tid, unsigned (&va)[1][2], int) const {
        asm volatile("" : "+v"(tid));
#pragma unroll
        for (int i = 0; i < 2; ++i) { int R, C; gm::stage_rc(tid * 16 + i * 8192, R, C); va[0][i] = (unsigned)((u.pm * 256 + R) * K + 2 * C); }
    }
};
struct SrcGateUp {
    const char* A; const char* Bt; const LAS int* ec; ETab T; int K;
    __device__ __forceinline__ const char* abase() const { return A; }
    __device__ __forceinline__ const char* bptr(const gm::Unit& u) const { const int e = T.pe[u.pm]; return Bt + ((size_t)e * 2048 + (size_t)u.pn * 256) * 2048; }
    static constexpr bool GATHER = true, FP8 = true;
    __device__ __forceinline__ void aoff(const gm::Unit& u, int tid, unsigned (&va)[2][2], int ui) const {
        asm volatile("" : "+v"(tid));
        const LAS int* ix = ec + (ui < EC_MAXU ? ui : EC_MAXU - 1) * 512;
#pragma unroll
        for (int i = 0; i < 2; ++i) { int R, C; gm::stage_rc(tid * 16 + i * 8192, R, C);
#pragma unroll
            for (int h = 0; h < 2; ++h) va[h][i] = (unsigned)(ix[h * 128 + R] * 2048 + 2 * C); }
    }
};
struct SrcDown {
    const char* A; const char* Bt; ETab T; int K;
    __device__ __forceinline__ const char* abase() const { return A; }
    __device__ __forceinline__ const char* bptr(const gm::Unit& u) const { const int e = T.pe[u.pm]; return Bt + ((size_t)e * 2048 + (size_t)u.pn * 256) * 1024; }
    static constexpr bool GATHER = false, FP8 = true;
    __device__ __forceinline__ void aoff(const gm::Unit& u, int tid, unsigned (&va)[1][2], int) const {
        asm volatile("" : "+v"(tid));
#pragma unroll
        for (int i = 0; i < 2; ++i) { int R, C; gm::stage_rc(tid * 16 + i * 8192, R, C); va[0][i] = (unsigned)((u.pm * 256 + R) * K + 2 * C); }
    }
};

#define EPI_BEGIN(ai, m) do { f32x4 _a0 = acc[ai][0][m][0], _a1 = acc[ai][0][m][1], _a2 = acc[ai][1][m][0], _a3 = acc[ai][1][m][1]; asm volatile("" : "+v"(_a0), "+v"(_a1), "+v"(_a2), "+v"(_a3)); A00 = _a0; A01 = _a1; A10 = _a2; A11 = _a3; } while (0)
#define EPI_END(x) asm volatile("" :: "v"(x) : "memory")
struct EpiInProj {
    bf16* PR; const LAS float* ec;
    __device__ __forceinline__ void operator()(const f32x4 (&acc)[2][2][4][2], const gm::Unit& u, int wr, int wc, int fr, int fq, int ui) const {
        const int pn = u.pn, lane = fq * 16 + fr;
        char* const ubase = (char*)PR + ((size_t)u.pm * 256 * DINM + 256 * pn) * 2;
        unsigned lo_qk = (unsigned)(((wr * 64 + fr) * DINM + 64 * wc + 16 * fq) * 2), lo_pl = (unsigned)(((wr * 64 + fr) * DINM + 32 * wc + 8 * fq) * 2);
        unsigned zz = 0, ro = (unsigned)((fr * 16 + 4 * fq) * 8), rq = (unsigned)(4 * fq * 8), nwo = (unsigned)(4 * fq * 4); asm volatile("" : "+v"(lo_qk), "+v"(lo_pl), "+v"(ro), "+v"(rq), "+v"(nwo), "+s"(zz));
        if (pn < 5) {
            const LAS char* nw = (const LAS char*)(ec + (pn < 4 ? 2048 : 2112));
            const float qs = pn < 4 ? 0.125f * LOG2E : 1.0f;
            const bool lat = u.pm < 64;
            f32x4 w[2][2];
#pragma unroll
            for (int bj = 0; bj < 2; ++bj)
#pragma unroll
                for (int n = 0; n < 2; ++n) w[bj][n] = *(const LAS f32x4*)(nw + nwo + (32 * bj + 16 * n) * 4);
#pragma unroll
            for (int ai = 0; ai < 2; ++ai) {
                f32x4 tr0, tr1, tc0[4], tc1[4];
                {
                    const int prow = (4 * u.pm + 2 * ai + wr) & 31;
                    const LAS float* rp = (const LAS float*)((const LAS char*)ec + prow * 128 + rq);
                    tr0 = *(const LAS f32x4*)rp; tr1 = *(const LAS f32x4*)(rp + 4);
                }
#pragma unroll
                for (int m = 0; m < 4; ++m) {
                    if ((m & 1) == 0) {
#pragma unroll
                        for (int mm = m; mm < m + 2; ++mm) { const LAS float* cp = (const LAS float*)((const LAS char*)ec + ro + mm * 2048); tc0[mm] = *(const LAS f32x4*)cp; tc1[mm] = *(const LAS f32x4*)(cp + 4); }
                    }
                    f32x4 y[2][2];
                    float ss = 0.f;
#pragma unroll
                    for (int bj = 0; bj < 2; ++bj)
#pragma unroll
                        for (int n = 0; n < 2; ++n) { const f32x4 v = acc[ai][bj][m][n] * W8I; y[bj][n] = v; ss += (v[0] * v[0] + v[1] * v[1]) + (v[2] * v[2] + v[3] * v[3]); }
                    ss += shx(ss, 16, lane); ss += shx(ss, 32, lane);
                    const float rstd = rsqrtf(ss * (1.0f / 64.0f) + EPS) * qs;
#pragma unroll
                    for (int bj = 0; bj < 2; ++bj)
#pragma unroll
                        for (int n = 0; n < 2; ++n) y[bj][n] = y[bj][n] * rstd * w[bj][n];
                    if (lat) {
#pragma unroll
                        for (int bj = 0; bj < 2; ++bj) {
                            const f32x4 t0 = bj ? tc0[m] : tr0, t1 = bj ? tc1[m] : tr1;
                            const f32x4 cs = (f32x4){t0[0], t0[2], t1[0], t1[2]}, sn = (f32x4){t0[1], t0[3], t1[1], t1[3]};
                            const f32x4 o0 = y[bj][0] * cs - y[bj][1] * sn, o1 = y[bj][1] * cs + y[bj][0] * sn;
                            y[bj][0] = o0; y[bj][1] = o1;
                        }
                    }
                    char* dst = ubase + (lo_qk + (unsigned)((ai * 128 + m * 16) * DINM * 2));
#pragma unroll
                    for (int bj = 0; bj < 2; ++bj) {
                        u32x4 pk; pk.x = cvt_pk_bf16(y[bj][0][0], y[bj][0][1]); pk.y = cvt_pk_bf16(y[bj][0][2], y[bj][0][3]); pk.z = cvt_pk_bf16(y[bj][1][0], y[bj][1][1]); pk.w = cvt_pk_bf16(y[bj][1][2], y[bj][1][3]);
                        *(u32x4*)(dst + 16 * bj) = pk;
                    }
                }
            }
        } else {
            const float sc = ((pn == 8 || pn == 9) ? 0.08838834764831845f : 1.0f) * W8I;
#pragma unroll
            for (int ai = 0; ai < 2; ++ai)
#pragma unroll
                for (int m = 0; m < 4; ++m) {
                    char* rowp = ubase + (lo_pl + (unsigned)((ai * 128 + m * 16) * DINM * 2));
#pragma unroll
                    for (int bj = 0; bj < 2; ++bj) {
                        const f32x4 v0 = acc[ai][bj][m][0] * sc, v1 = acc[ai][bj][m][1] * sc;
                        u32x4 pk; pk.x = cvt_pk_bf16(v0[0], v0[1]); pk.y = cvt_pk_bf16(v0[2], v0[3]); pk.z = cvt_pk_bf16(v1[0], v1[1]); pk.w = cvt_pk_bf16(v1[2], v1[3]);
                        *(u32x4*)(rowp + 256 * bj) = pk;
                    }
                }
        }
    }
};
struct EpiOutProj {
    const float* baseLat; const float* baseCtx; const bf16* baseB; bf16* outp; const float* g1; int wvi;
    __device__ __forceinline__ void operator()(const f32x4 (&acc)[2][2][4][2], const gm::Unit& u, int wr, int wc, int fr, int fq, int ui) const {
        const int pm = u.pm;
        const int mb = pm < 64 ? (pm >> 3) : 8;
        { const int l2 = otid(wvi) & 63; fr = l2 & 15; fq = l2 >> 4; }
        const int col0 = 256 * u.pn + 32 * wc + 8 * fq;
        char* const obase = (char*)outp + (size_t)pm * 256 * DM * 2;
        unsigned lo0 = (unsigned)((wr * 64 + fr) * DM + col0); unsigned zz = 0; asm volatile("" : "+v"(lo0), "+s"(zz));
        const float* gp = g1 + (size_t)mb * MODW + col0 + zz;
        f32x4 gv[2][2];
#pragma unroll
        for (int bj = 0; bj < 2; ++bj)
#pragma unroll
            for (int n = 0; n < 2; ++n) gv[bj][n] = *(const f32x4*)(gp + 128 * bj + 4 * n) * (W8I * C8I);
#pragma unroll
        for (int ai = 0; ai < 2; ++ai) {
            f32x4 bs[4][2][2];
            if (baseB) {
                const char* bb = (const char*)baseB + (size_t)pm * 256 * DM * 2;
#pragma unroll
                for (int m = 0; m < 4; ++m)
#pragma unroll
                    for (int bj = 0; bj < 2; ++bj) { const u32x4 w = *(const u32x4*)(bb + ((lo0 + (unsigned)((ai * 128 + m * 16) * DM) + 128 * bj) * 2));
                        bs[m][bj][0] = (f32x4){bflo(w.x), bfhi(w.x), bflo(w.y), bfhi(w.y)}; bs[m][bj][1] = (f32x4){bflo(w.z), bfhi(w.z), bflo(w.w), bfhi(w.w)}; }
            } else {
                const char* bf = (const char*)(pm < 64 ? baseLat + (size_t)pm * 256 * DM : baseCtx + (size_t)(pm - 64) * 256 * DM);
#pragma unroll
                for (int m = 0; m < 4; ++m)
#pragma unroll
                    for (int bj = 0; bj < 2; ++bj)
#pragma unroll
                        for (int n = 0; n < 2; ++n) bs[m][bj][n] = *(const f32x4*)(bf + ((lo0 + (unsigned)((ai * 128 + m * 16) * DM) + 128 * bj + 4 * n) * 4));
            }
#pragma unroll
            for (int m = 0; m < 4; ++m)
#pragma unroll
                for (int bj = 0; bj < 2; ++bj) {
                    const f32x4 o0 = bs[m][bj][0] + gv[bj][0] * acc[ai][bj][m][0], o1 = bs[m][bj][1] + gv[bj][1] * acc[ai][bj][m][1];
                    u32x4 pk; pk.x = cvt_pk_bf16(o0[0], o0[1]); pk.y = cvt_pk_bf16(o0[2], o0[3]); pk.z = cvt_pk_bf16(o1[0], o1[1]); pk.w = cvt_pk_bf16(o1[2], o1[3]);
                    *(u32x4*)(obase + ((lo0 + (unsigned)((ai * 128 + m * 16) * DM) + 128 * bj) * 2)) = pk;
                }
        }
    }
};
struct EpiGateUp {
    bf16* H; const LAS float* ec; ETab T;
    __device__ __forceinline__ void operator()(const f32x4 (&acc)[2][2][4][2], const gm::Unit& u, int wr, int wc, int fr, int fq, int ui) const {
        const int e = T.pe[u.pm], j0 = 128 * u.pn + 32 * wc + 8 * fq;
        char* const hbase = (char*)H + (size_t)u.pm * 256 * DFF;
        unsigned lo0 = (unsigned)((wr * 64 + fr) * DFF + j0); unsigned zz = 0; asm volatile("" : "+v"(lo0), "+s"(zz));
        const LAS float* bgp = ec + (ui < EC_MAXU ? ui : EC_MAXU - 1) * 512 + 256 + 32 * wc + 8 * fq;
        f32x4 bg[2], bu[2];
#pragma unroll
        for (int n = 0; n < 2; ++n) { bg[n] = *(const LAS f32x4*)(bgp + 4 * n); bu[n] = *(const LAS f32x4*)(bgp + 128 + 4 * n); }
#pragma unroll
        for (int ai = 0; ai < 2; ++ai)
#pragma unroll
            for (int m = 0; m < 4; ++m) {
                float hv[8];
#pragma unroll
                for (int n = 0; n < 2; ++n)
#pragma unroll
                    for (int i = 0; i < 4; ++i) {
                        const float gt = fminf(acc[ai][0][m][n][i] * W8I + bg[n][i], 7.0f);
                        const float up = fminf(fmaxf(acc[ai][1][m][n][i] * W8I + bu[n][i], -7.0f), 7.0f);
                        hv[4 * n + i] = (up + 1.0f) * gt * sigmoidf_(1.702f * gt);
                    }
                u32x2 pk; pk.x = pk4_fp8(hv[0], hv[1], hv[2], hv[3]); pk.y = pk4_fp8(hv[4], hv[5], hv[6], hv[7]);
                *(u32x2*)(hbase + (lo0 + (unsigned)((ai * 128 + m * 16) * DFF))) = pk;
            }
    }
};
struct EpiDown {
    bf16* Y; const LAS float* ec; ETab T;
    __device__ __forceinline__ void operator()(const f32x4 (&acc)[2][2][4][2], const gm::Unit& u, int wr, int wc, int fr, int fq, int ui) const {
        const int e = T.pe[u.pm], lp = u.pm - T.pbase[e], ne = T.cnt[e];
        const int col0 = 256 * u.pn + 64 * wc + 16 * fq;
        char* const ybase = (char*)Y + (size_t)u.pm * 256 * DM;
        unsigned lo0 = (unsigned)((wr * 64 + fr) * DM + col0); unsigned zz = 0; asm volatile("" : "+v"(lo0), "+s"(zz));
        const LAS float* ecu = ec + (ui < EC_MAXU ? ui : EC_MAXU - 1) * 512;
        f32x4 bv[2][2]; float wt[2][4];
#pragma unroll
        for (int bj = 0; bj < 2; ++bj)
#pragma unroll
            for (int n = 0; n < 2; ++n) bv[bj][n] = *(const LAS f32x4*)(ecu + 64 * wc + 16 * fq + 8 * bj + 4 * n);
#pragma unroll
        for (int ai = 0; ai < 2; ++ai)
#pragma unroll
            for (int m = 0; m < 4; ++m) wt[ai][m] = ecu[256 + ai * 128 + wr * 64 + m * 16 + fr];
#pragma unroll
        for (int ai = 0; ai < 2; ++ai)
#pragma unroll
            for (int m = 0; m < 4; ++m) {
                char* rowp = ybase + (lo0 + (unsigned)((ai * 128 + m * 16) * DM));
                const float ws_ = wt[ai][m] * Y8S;
                u32x4 pk;
                { const f32x4 v0 = (acc[ai][0][m][0] * W8I + bv[0][0]) * ws_, v1 = (acc[ai][0][m][1] * W8I + bv[0][1]) * ws_; pk.x = pk4_fp8(v0[0], v0[1], v0[2], v0[3]); pk.y = pk4_fp8(v1[0], v1[1], v1[2], v1[3]); }
                { const f32x4 v0 = (acc[ai][1][m][0] * W8I + bv[1][0]) * ws_, v1 = (acc[ai][1][m][1] * W8I + bv[1][1]) * ws_; pk.z = pk4_fp8(v0[0], v0[1], v0[2], v0[3]); pk.w = pk4_fp8(v1[0], v1[1], v1[2], v1[3]); }
                *(u32x4*)rowp = pk;
            }
    }
};

#define XB_TMO      128
#define XB_XCNT(j)  (256  + 64 * (j))
#define XB_XSUB(j)  (1280 + 64 * (j))
#define XB_XGEN(j)  (2304 + 64 * (j))
#define XB_TOP      3328
#define XB_TOPGEN   3392
#define XCD_BAR_WORDS 3456
#define XB_SPIN_CAP (1u << 24)
__device__ __forceinline__ unsigned xb_ld(unsigned* p)              { return __hip_atomic_load(p, __ATOMIC_RELAXED, __HIP_MEMORY_SCOPE_AGENT); }
__device__ __forceinline__ unsigned xb_add(unsigned* p, unsigned v) { return __hip_atomic_fetch_add(p, v, __ATOMIC_RELAXED, __HIP_MEMORY_SCOPE_AGENT); }
__device__ __forceinline__ unsigned xb_xcc_id() { return (unsigned)__builtin_amdgcn_s_getreg((3 << 11) | 20) & 0xFu; }
#define XB_SPIN(cond, bar) do { unsigned _sp = 0; while (cond) { __builtin_amdgcn_s_sleep(1); \
    if ((++_sp & 255u) == 0u) { if (xb_ld(&(bar)[XB_TMO])) break; if (_sp > XB_SPIN_CAP) { atomicAdd(&(bar)[XB_TMO], 1u); break; } } } } while (0)
struct XcdBarrier { unsigned* bar; unsigned x; volatile LAS unsigned* st; int wv; };
__device__ __forceinline__ XcdBarrier xcd_barrier_post(unsigned* bar, volatile LAS unsigned* st, int wv_) {
    XcdBarrier b; b.bar = bar; b.x = xb_xcc_id(); b.st = st; b.wv = wv_;
    if (otid(wv_) == 0) (void)xb_add(&bar[XB_XCNT(b.x)], 1u);
    return b;
}
__device__ __forceinline__ void xcd_barrier_complete(unsigned* bar, unsigned x, unsigned& nloc, unsigned& nx) {
    const unsigned G = gridDim.x * gridDim.y * gridDim.z;
    unsigned sum, cnt, mine, sp = 0u;
    for (;;) {
        sum = 0u; cnt = 0u; mine = 0u;
#pragma clang loop unroll(disable) vectorize(disable)
        for (unsigned j = 0; j < 16; ++j) { const unsigned c = xb_ld(&bar[XB_XCNT(j)]); sum += c; cnt += (c > 0u) ? 1u : 0u; mine = (j == x) ? c : mine; }
        if (sum == G) break;
        __builtin_amdgcn_s_sleep(1);
        if ((++sp & 255u) == 0u) { if (xb_ld(&bar[XB_TMO])) break; if (sp > XB_SPIN_CAP) { atomicAdd(&bar[XB_TMO], 1u); break; } }
    }
    nloc = mine > 0u ? mine : 1u; nx = cnt > 0u ? cnt : 1u;
}
__device__ __forceinline__ void xcd_barrier(const XcdBarrier& b) {
    const int wv_ = b.wv;
    asm volatile("s_waitcnt vmcnt(0)" ::: "memory");
    __syncthreads();
    if (otid(wv_) == 0) {
        unsigned* bar = b.bar; asm volatile("" : "+s"(bar));
        __builtin_amdgcn_s_waitcnt(0);
        unsigned nloc = b.st[0], nx = b.st[1];
        if (nloc == 0u) { xcd_barrier_complete(bar, b.x, nloc, nx); b.st[0] = nloc; b.st[1] = nx; }
        const unsigned old = xb_add(&bar[XB_XSUB(b.x)], 1u);
        const unsigned gen = old / nloc;
        if (old + 1u == (gen + 1u) * nloc) {
            __builtin_amdgcn_fence(__ATOMIC_RELEASE, "agent");
            asm volatile("s_waitcnt vmcnt(0)" ::: "memory");
            const unsigned og = xb_add(&bar[XB_TOP], 1u);
            const unsigned tg = og / nx;
            if (og + 1u == (tg + 1u) * nx) xb_add(&bar[XB_TOPGEN], 1u);
            else XB_SPIN(xb_ld(&bar[XB_TOPGEN]) == tg, bar);
            __builtin_amdgcn_fence(__ATOMIC_ACQUIRE, "agent");
            xb_add(&bar[XB_XGEN(b.x)], 1u);
            asm volatile("s_waitcnt vmcnt(0)" ::: "memory");
        } else {
            XB_SPIN(xb_ld(&bar[XB_XGEN(b.x)]) == gen, bar);
            __builtin_amdgcn_fence(__ATOMIC_ACQUIRE, "agent");
            asm volatile("s_waitcnt vmcnt(0)" ::: "memory");
        }
    }
    __syncthreads();
}

__device__ __forceinline__ void conv_item(const float* W, int ldw, int K, int k0, int src0, bf16* WT, size_t dstrow0, bool perm, LAS float* scr, int lane) {
    f32x4 v[8];
#pragma unroll
    for (int i = 0; i < 8; ++i) v[i] = *(const f32x4*)(W + (size_t)(k0 + (lane >> 3) + 8 * i) * ldw + src0 + 4 * (lane & 7));
#pragma unroll
    for (int i = 0; i < 8; ++i) { LAS float* s = scr + ((lane >> 3) + 8 * i) * 33 + 4 * (lane & 7); s[0] = v[i][0]; s[1] = v[i][1]; s[2] = v[i][2]; s[3] = v[i][3]; }
    LDS_WAIT(); asm volatile("" ::: "memory");
    const int c = lane & 7;
#pragma unroll
    for (int jj = 0; jj < 4; ++jj) {
        const int j = (lane >> 3) + 8 * jj, sc = perm ? gm::perm32(j) : j;
        const LAS float* s = scr + (8 * c) * 33 + sc;
        u32x4 o; o.x = pk2(s[0 * 33], s[1 * 33]); o.y = pk2(s[2 * 33], s[3 * 33]); o.z = pk2(s[4 * 33], s[5 * 33]); o.w = pk2(s[6 * 33], s[7 * 33]);
        *(u32x4*)(WT + (dstrow0 + j) * (size_t)K + k0 + 8 * c) = o;
    }
    LDS_WAIT(); asm volatile("" ::: "memory");
}

__device__ __forceinline__ void conv_item8(const float* W, int ldw, int K, int k0, int src0, unsigned char* WT8, size_t dstrow0, bool perm, LAS float* scr, int lane) {
    f32x4 v[8];
#pragma unroll
    for (int i = 0; i < 8; ++i) v[i] = *(const f32x4*)(W + (size_t)(k0 + (lane >> 3) + 8 * i) * ldw + src0 + 4 * (lane & 7));
#pragma unroll
    for (int i = 0; i < 8; ++i) { LAS float* s = scr + ((lane >> 3) + 8 * i) * 33 + 4 * (lane & 7); s[0] = v[i][0]; s[1] = v[i][1]; s[2] = v[i][2]; s[3] = v[i][3]; }
    LDS_WAIT(); asm volatile("" ::: "memory");
    const int j = lane >> 1, hf = lane & 1, sc = perm ? gm::perm32(j) : j;
    const LAS float* s = scr + (32 * hf) * 33 + sc;
    u32x4 o0, o1;
    o0.x = pk4_fp8(s[0 * 33] * W8S, s[1 * 33] * W8S, s[2 * 33] * W8S, s[3 * 33] * W8S);     o0.y = pk4_fp8(s[4 * 33] * W8S, s[5 * 33] * W8S, s[6 * 33] * W8S, s[7 * 33] * W8S);
    o0.z = pk4_fp8(s[8 * 33] * W8S, s[9 * 33] * W8S, s[10 * 33] * W8S, s[11 * 33] * W8S);   o0.w = pk4_fp8(s[12 * 33] * W8S, s[13 * 33] * W8S, s[14 * 33] * W8S, s[15 * 33] * W8S);
    o1.x = pk4_fp8(s[16 * 33] * W8S, s[17 * 33] * W8S, s[18 * 33] * W8S, s[19 * 33] * W8S); o1.y = pk4_fp8(s[20 * 33] * W8S, s[21 * 33] * W8S, s[22 * 33] * W8S, s[23 * 33] * W8S);
    o1.z = pk4_fp8(s[24 * 33] * W8S, s[25 * 33] * W8S, s[26 * 33] * W8S, s[27 * 33] * W8S); o1.w = pk4_fp8(s[28 * 33] * W8S, s[29 * 33] * W8S, s[30 * 33] * W8S, s[31 * 33] * W8S);
    unsigned char* d = WT8 + (dstrow0 + j) * (size_t)K + k0 + 32 * hf;
    *(u32x4*)d = o0; *(u32x4*)(d + 16) = o1;
    LDS_WAIT(); asm volatile("" ::: "memory");
}

struct CvItem { const float* src; unsigned char* dst; int ldw, K, k0; size_t dstrow0; bool perm, f8, p64; };
constexpr int CV_I_IN = 16 * 144, CV_I_OUT = 16 * 64, CV_I_GU = 16 * 64, CV_I_D = 8 * 64;
constexpr int CV_N_IN = DEPTH * CV_I_IN, CV_N_OUT = DEPTH * CV_I_OUT, CV_N_GU = DEPTH * NEXP * CV_I_GU, CV_N_D = DEPTH * NEXP * CV_I_D, CV_N_ALL = CV_N_IN + CV_N_OUT + CV_N_GU + CV_N_D;
constexpr int CV_NQ = CV_N_D / 2;
constexpr int CV_NPJ = CV_N_IN + CV_N_OUT;
constexpr int CV_NP = 0;
__device__ __forceinline__ int cv_pmap(int p) { return p; }
constexpr int CV_D0 = CV_N_IN + CV_N_OUT + CV_N_GU;
constexpr int CV_G0 = CV_N_IN + CV_N_OUT;
__device__ __forceinline__ int cv_qmap(int q) { return CV_N_IN + CV_N_OUT + CV_N_GU + CV_N_D / 2 + q; }
__device__ __forceinline__ CvItem cv_decode(LAS unsigned char* lds, int it) {
    unsigned char* ws = ((unsigned char*)AP(ws));
    CvItem d; d.p64 = false; int r = it;
    if (r < CV_N_IN) {
        const int l = r / CV_I_IN; r %= CV_I_IN; const int kb = r / 144, g = r % 144, pn = g >> 3, c0 = (g & 7) * 32;
        int src0; if (pn < 5) { const int bj = c0 >> 7, wc = (c0 >> 5) & 3; src0 = 256 * pn + 64 * wc + 32 * bj; d.perm = false; } else { src0 = 256 * pn + c0; d.perm = true; }
        d.src = AP(w_in) + (size_t)l * DM * DIN + src0; d.ldw = DIN; d.K = DM; d.k0 = kb * 128; d.dst = (unsigned char*)(ws + WS_WIN) + (size_t)l * DINM * DM; d.dstrow0 = (size_t)g * 32; d.f8 = true; return d;
    }
    r -= CV_N_IN;
    if (r < CV_N_OUT) {
        const int l = r / CV_I_OUT; r %= CV_I_OUT; const int kb = r / 64, g = r % 64;
        d.src = AP(w_out) + (size_t)l * DM * DM + g * 32; d.ldw = DM; d.K = DM; d.k0 = kb * 128; d.dst = (unsigned char*)(ws + WS_WOUT) + (size_t)l * DM * DM; d.dstrow0 = (size_t)g * 32; d.perm = true; d.f8 = true; return d;
    }
    r -= CV_N_OUT;
    if (r < CV_N_GU) {
        const int le = r / CV_I_GU; r %= CV_I_GU; const int kb = (r & 7) + 8 * (r >> 9), g = (r >> 3) & 63, pn = g >> 3,        c0 = (g & 7) * 32, bj = c0 >> 7, gg = (c0 >> 5) & 3;
        d.src = AP(w_gate_up) + (size_t)le * DM * 2048 + bj * 1024 + 128 * pn + 32 * gg; d.ldw = 2048; d.K = DM; d.k0 = kb * 128; d.dst = (unsigned char*)(ws + WS_WGU) + (size_t)le * 2048 * DM; d.dstrow0 = (size_t)g * 32; d.perm = true; d.f8 = true; return d;
    }
    r -= CV_N_GU;
    const int le = r / CV_I_D; r %= CV_I_D; const int kb = r & 7, g = r >> 3;
    d.src = AP(w_down) + (size_t)le * DFF * DM + (g >> 3) * 256 + 64 * (g & 3) + 8 * ((g >> 2) & 1); d.ldw = DM; d.K = DFF; d.k0 = kb * 128; d.dst = (unsigned char*)(ws + WS_WD) + (size_t)le * DM * DFF; d.dstrow0 = (size_t)g * 32; d.perm = true; d.f8 = true; d.p64 = true; return d;
}
__device__ __forceinline__ void cv_issue(const CvItem& d, f32x4 (&v)[16], int lane) {
    const int co = d.p64 ? 16 * ((lane & 7) >> 1) + 4 * (lane & 1) : 4 * (lane & 7);
#pragma unroll
    for (int i = 0; i < 16; ++i) if (i < 8 || d.f8) v[i] = __builtin_nontemporal_load((const f32x4*)(d.src + (size_t)(d.k0 + (lane >> 3) + 8 * i) * d.ldw + co));
}
__device__ __forceinline__ void cv_to_lds(const CvItem& d, const f32x4 (&v)[16], LAS float* scr, int lane) {
#pragma unroll
    for (int i = 0; i < 16; ++i) if (i < 8 || d.f8) { LAS float* sp = scr + ((lane >> 3) + 8 * i) * 33 + 4 * (lane & 7); sp[0] = v[i][0]; sp[1] = v[i][1]; sp[2] = v[i][2]; sp[3] = v[i][3]; }
    LDS_WAIT(); asm volatile("" ::: "memory");
}
__device__ __forceinline__ void cv_finish(const CvItem& d, LAS float* scr, int lane) {
    if (d.f8) {
        const int j = lane >> 1, hf = lane & 1, scn = d.perm ? gm::perm32(j) : j;
        const LAS float* sp = scr + (64 * hf) * 33 + scn;
        unsigned char* dp = d.dst + (d.dstrow0 + j) * (size_t)d.K + d.k0 + 64 * hf;
#pragma unroll
        for (int q = 0; q < 4; ++q) {
            u32x4 o;
            o.x = pk4_fp8(sp[(16 * q + 0) * 33] * W8S, sp[(16 * q + 1) * 33] * W8S, sp[(16 * q + 2) * 33] * W8S, sp[(16 * q + 3) * 33] * W8S);
            o.y = pk4_fp8(sp[(16 * q + 4) * 33] * W8S, sp[(16 * q + 5) * 33] * W8S, sp[(16 * q + 6) * 33] * W8S, sp[(16 * q + 7) * 33] * W8S);
            o.z = pk4_fp8(sp[(16 * q + 8) * 33] * W8S, sp[(16 * q + 9) * 33] * W8S, sp[(16 * q + 10) * 33] * W8S, sp[(16 * q + 11) * 33] * W8S);
            o.w = pk4_fp8(sp[(16 * q + 12) * 33] * W8S, sp[(16 * q + 13) * 33] * W8S, sp[(16 * q + 14) * 33] * W8S, sp[(16 * q + 15) * 33] * W8S);
            *(u32x4*)(dp + 16 * q) = o;
        }
    } else {
        const int c = lane & 7;
#pragma unroll
        for (int jj = 0; jj < 4; ++jj) {
            const int j = (lane >> 3) + 8 * jj, scn = d.perm ? gm::perm32(j) : j;
            const LAS float* sp = scr + (8 * c) * 33 + scn;
            u32x4 o; o.x = pk2(sp[0 * 33], sp[1 * 33]); o.y = pk2(sp[2 * 33], sp[3 * 33]); o.z = pk2(sp[4 * 33], sp[5 * 33]); o.w = pk2(sp[6 * 33], sp[7 * 33]);
            *(u32x4*)(d.dst + ((d.dstrow0 + j) * (size_t)d.K + d.k0 + 8 * c) * 2) = o;
        }
    }
    LDS_WAIT(); asm volatile("" ::: "memory");
}
#ifndef FS_CAP0
#define FS_CAP0 24
#define FS_CAP1 20
#define FS_CAP2 22
#define FS_CAP3 24
#endif
constexpr int CV_FW = 1;
constexpr int CW_PROG = 65536;
__device__ __forceinline__ int fs_rem(int s, int G) { const int n = s == 0 ? 72 * 18 : (s == 3 ? 64 * 18 + 64 : 576); return n % G; }
__device__ __forceinline__ int fs_cap(int s) { return s == 0 ? FS_CAP0 : s == 1 ? FS_CAP1 : s == 2 ? FS_CAP2 : FS_CAP3; }
__device__ __forceinline__ void fs_params(int s, int bx, int vcu, int G, int& rank, int& nidle, int& qb) {
    qb = 0;
    for (int j = 0; j < s; ++j) { const int r = fs_rem(j, G); qb += (r ? G - r : 0) * CV_FW * fs_cap(j); }
    const int r = fs_rem(s, G); nidle = r ? G - r : 0; rank = r ? (s == 1 ? vcu : bx) - r : -1;
}
__device__ __forceinline__ int fs_total(int G) { int q = 0; for (int j = 0; j < 4; ++j) { const int r = fs_rem(j, G); q += (r ? G - r : 0) * CV_FW * fs_cap(j); } return (G <= 256 && q <= CV_NQ) ? q : -1; }
__device__ __forceinline__ void conv_fill(LAS unsigned char* lds, int wv_, int s, int bx, int vcu, int G) {
    const int tid = otid(wv_), lane = tid & 63, wave = __builtin_amdgcn_readfirstlane(tid >> 6);
    unsigned* ctl = (unsigned*)(((unsigned char*)AP(ws)) + WS_CTL);
    unsigned* dn = ctl + CW_TD + 16 * s;
    __syncthreads();
    if (tid == 0) __hip_atomic_fetch_add(dn, 1u, __ATOMIC_RELAXED, __HIP_MEMORY_SCOPE_AGENT);
    int rank, nidle, qb; fs_params(s, bx, vcu, G, rank, nidle, qb);
    if (rank >= 0 && wave < CV_FW && fs_total(G) >= 0) {
        const int K = fs_cap(s), stride = nidle * CV_FW, q0 = qb + rank * CV_FW + wave;
        LAS float* scr = (LAS float*)(lds + wave * 17408);
        f32x4 va[16];
        int k = 0;
        unsigned dv = __hip_atomic_load(dn, __ATOMIC_RELAXED, __HIP_MEMORY_SCOPE_AGENT);
        if ((int)__builtin_amdgcn_readfirstlane(dv) < G) {
            CvItem da = cv_decode(lds, cv_qmap(q0)); cv_issue(da, va, lane);
#pragma clang loop unroll(disable)
            for (;;) {
                const CvItem d = da;
                cv_to_lds(d, va, scr, lane);
                dv = __hip_atomic_load(dn, __ATOMIC_RELAXED, __HIP_MEMORY_SCOPE_AGENT);
                const bool more = k + 1 < K;
                if (more) { da = cv_decode(lds, cv_qmap(q0 + (k + 1) * stride)); cv_issue(da, va, lane); }
                cv_finish(d, scr, lane);
                ++k;
                if (!more || (int)__builtin_amdgcn_readfirstlane(dv) >= G) break;
            }
        }
        if (lane == 0) __hip_atomic_store(ctl + CW_PROG + (s * 256 + bx) * 8 + wave, (unsigned)k, __ATOMIC_RELAXED, __HIP_MEMORY_SCOPE_AGENT);
    }
    __syncthreads();
}
__device__ __forceinline__ void conv_drain(LAS unsigned char* lds, int wv_, int bx, int vcu, int G) {
    const int tid = otid(wv_), lane = tid & 63, wave = __builtin_amdgcn_readfirstlane(tid >> 6);
    unsigned* ctl = (unsigned*)(((unsigned char*)AP(ws)) + WS_CTL);
    __syncthreads();
    LAS float* scr = (LAS float*)(lds + wave * 17408);
    f32x4 va[16];
    const int qt = fs_total(G);
    if (qt >= 0) {
        int pos = 0;
#pragma clang loop unroll(disable)
        for (int s = 0; s < 4; ++s) {
            int rank, nidle, qb; fs_params(s, bx, vcu, G, rank, nidle, qb);
            if (rank < 0) continue;
            const int K = fs_cap(s), stride = nidle * CV_FW;
#pragma clang loop unroll(disable)
            for (int w = 0; w < CV_FW; ++w) {
                const int k0 = (int)__builtin_amdgcn_readfirstlane(__hip_atomic_load(ctl + CW_PROG + (s * 256 + bx) * 8 + w, __ATOMIC_RELAXED, __HIP_MEMORY_SCOPE_AGENT));
#pragma clang loop unroll(disable)
                for (int k = k0; k < K; ++k, ++pos) {
                    if ((pos & 7) != wave) continue;
                    const CvItem d = cv_decode(lds, cv_qmap(qb + k * stride + rank * CV_FW + w));
                    cv_issue(d, va, lane); cv_to_lds(d, va, scr, lane); cv_finish(d, scr, lane);
                }
            }
        }
    }
    {
        const int NGW = G * 8, first = (qt >= 0 ? qt : 0) + vcu * 8 + wave;
        CvItem da = cv_decode(lds, cv_qmap(first < CV_NQ ? first : 0));
        if (first < CV_NQ) cv_issue(da, va, lane);
#pragma clang loop unroll(disable)
        for (int it = first; it < CV_NQ; it += NGW) {
            const CvItem d = da;
            cv_to_lds(d, va, scr, lane);
            if (it + NGW < CV_NQ) { da = cv_decode(lds, cv_qmap(it + NGW)); cv_issue(da, va, lane); }
            cv_finish(d, scr, lane);
        }
    }
    __syncthreads();
}

__device__ __forceinline__ void conv_static(LAS unsigned char* lds, int wv_, int base, int count, int vcu, int G) {
    const int tid = otid(wv_), lane = tid & 63, wave = __builtin_amdgcn_readfirstlane(tid >> 6);
    __syncthreads();
    LAS float* scr = (LAS float*)(lds + wave * 17408);
    f32x4 va[16], vb[16];
    const int NGW = G * 8, first = vcu * 8 + wave;
    CvItem da = cv_decode(lds, base + (first < count ? first : 0)), db = cv_decode(lds, base + (first + NGW < count ? first + NGW : 0));
    if (first < count) cv_issue(da, va, lane);
    if (first + NGW < count) cv_issue(db, vb, lane);
#pragma clang loop unroll(disable)
    for (int it = first; it < count; it += 2 * NGW) {
        {
            const CvItem d = da;
            cv_to_lds(d, va, scr, lane);
            if (it + 2 * NGW < count) { da = cv_decode(lds, base + it + 2 * NGW); cv_issue(da, va, lane); }
            cv_finish(d, scr, lane);
        }
        if (it + NGW < count) {
            const CvItem d = db;
            cv_to_lds(d, vb, scr, lane);
            if (it + 3 * NGW < count) { db = cv_decode(lds, base + it + 3 * NGW); cv_issue(db, vb, lane); }
            cv_finish(d, scr, lane);
        }
    }
    __syncthreads();
}

__device__ __forceinline__ void phase_prologue(LAS unsigned char* lds, int wv_, int vcu, int G) {
    const int tid = otid(wv_), lane = tid & 63, wave = __builtin_amdgcn_readfirstlane(tid >> 6);
    unsigned char* ws = ((unsigned char*)AP(ws));
    {
        const int gt = vcu * 512 + tid, NG = G * 512;
        float* rope = (float*)(ws + WS_ROPE);
        for (int it = gt; it < 64 * 16; it += NG) {
            const int pos = it >> 4, f = it & 15;
            double th = 1.0; for (int j = 0; j < f; ++j) th *= 0.5623413251903491;
            double s1 = 0.0, c1 = 0.0, term = 1.0;
            for (int n = 0; n < 24; ++n) { if ((n & 1) == 0) c1 += ((n >> 1) & 1) ? -term : term; else s1 += ((n >> 1) & 1) ? -term : term; term *= th / (double)(n + 1); }
            double cr = 1.0, sr = 0.0;
            for (int j = 0; j < pos; ++j) { const double nc = cr * c1 - sr * s1, ns = sr * c1 + cr * s1; cr = nc; sr = ns; }
            rope[it * 2] = (float)cr; rope[it * 2 + 1] = (float)sr;
        }
        float* wgp = (float*)(ws + WS_WGP);
        for (int it = gt; it < DEPTH * DM * 16; it += NG) {
            const int l = it / (DM * 16), r = it % (DM * 16), k = r >> 4, j = r & 15;
            const int s = k >> 5, g = (k >> 3) & 3, i = k & 7;
            wgp[(size_t)l * DM * 16 + ((s * 4 + g) * 16 + j) * 8 + i] = AP(w_in)[((size_t)l * DM + k) * DIN + DINM + j];
        }
        float* wrp = (float*)(ws + WS_WRP);
        for (int it = gt; it < DEPTH * DM * 32; it += NG) {
            const int l = it / (DM * 32), r = it % (DM * 32), k = r >> 5, jj = r & 31, tile = jj >> 4, j = jj & 15;
            const int s = k >> 5, g = (k >> 3) & 3, i = k & 7;
            wrp[(size_t)l * DM * 32 + (((s * 4 + g) * 2 + tile) * 16 + j) * 8 + i] = AP(w_router)[((size_t)l * DM + k) * NEXP + jj];
        }
    }
    {
        __syncthreads();
        LAS float* sc = (LAS float*)lds;
        LAS float* red = (LAS float*)(lds + 73728);
        bool staged = false;
        for (int it = vcu; it < 256; it += G) {
            if (!staged) {
                for (int i = tid; i < 9 * DM; i += 512) { const int r = i / DM, k = i % DM; const float v = r < 8 ? AP(c)[r * DM + k] : AP(c_ctx)[k]; sc[i] = v / (1.0f + __expf(-v)); }
                staged = true;
            }
            __syncthreads();
            const int l = it >> 7, cg = it & 127, lc = lane < 48 ? lane : 47, col = cg * 96 + 2 * lc;
            const float* W = AP(w_ada) + (size_t)l * DM * MODW + col;
            float acc[9][2];
#pragma unroll
            for (int r = 0; r < 9; ++r) { acc[r][0] = 0.f; acc[r][1] = 0.f; }
            for (int k16 = 0; k16 < 16; ++k16) {
                const int k = wave * 256 + k16 * 16;
                f32x2 w[16];
#pragma unroll
                for (int j = 0; j < 16; ++j) w[j] = *(const f32x2*)(W + (size_t)(k + j) * MODW);
#pragma unroll
                for (int r = 0; r < 9; ++r) {
#pragma unroll
                    for (int q = 0; q < 4; ++q) {
                        const f32x4 sv = *(const LAS f32x4*)(sc + r * DM + k + 4 * q);
#pragma unroll
                        for (int j = 0; j < 4; ++j) { acc[r][0] += sv[j] * w[4 * q + j][0]; acc[r][1] += sv[j] * w[4 * q + j][1]; }
                    }
                }
            }
            if (lane < 48) {
#pragma unroll
                for (int r = 0; r < 9; ++r) { red[(wave * 9 + r) * 96 + 2 * lane] = acc[r][0]; red[(wave * 9 + r) * 96 + 2 * lane + 1] = acc[r][1]; }
            }
            __syncthreads();
            for (int i = tid; i < 9 * 96; i += 512) {
                const int r = i / 96, cc = i % 96; float sum = 0.f;
#pragma unroll
                for (int w = 0; w < 8; ++w) sum += red[(w * 9 + r) * 96 + cc];
                ((float*)(ws + WS_MOD))[((size_t)l * 9 + r) * MODW + cg * 96 + cc] = sum + AP(b_ada)[(size_t)l * MODW + cg * 96 + cc];
            }
        }
        __syncthreads();
    }
    {
        LAS float* scr = (LAS float*)(lds + wave * 17408);
        const int gw = vcu * 8 + wave, NGW = G * 8;
        f32x4 va[16];
        CvItem da = cv_decode(lds, cv_pmap(gw < CV_NP ? gw : 0));
        if (gw < CV_NP) cv_issue(da, va, lane);
        for (int it = gw; it < CV_NP; it += NGW) {
            const CvItem d = da;
            cv_to_lds(d, va, scr, lane);
            if (it + NGW < CV_NP) { da = cv_decode(lds, cv_pmap(it + NGW)); cv_issue(da, va, lane); }
            cv_finish(d, scr, lane);
        }
    }
}

template <bool ROUTER, bool COMBINE, bool XBF  >
__device__ __forceinline__ void phase_norm(LAS unsigned char* lds, int wv_, int layer, int vcu, int G) {
    const int tid = otid(wv_), lane = tid & 63, wave = __builtin_amdgcn_readfirstlane(tid >> 6), r = lane & 15, g = lane >> 4;
    unsigned char* ws = ((unsigned char*)AP(ws));
    const float* MOD = (const float*)(ws + WS_MOD) + (size_t)layer * 9 * MODW;
    const float* nw = (ROUTER ? AP(norm2_w) : AP(norm1_w)) + (size_t)layer * DM;
    const int off_sh = ROUTER ? 3 * DM : 0, off_sc = ROUTER ? 4 * DM : DM;
    const int nrows = ROUTER ? (layer == 0 ? TT : TL) : TT;
    const int ngroups = nrows / 16;
    constexpr bool combine = COMBINE;
    LAS float* part0 = (LAS float*)(lds);
    LAS float* red0 = (LAS float*)(lds + 1024);
    LAS float* logit0 = (LAS float*)(lds + 1024 + 32768);
    LAS float* topv0 = logit0 + 1024;
    LAS int* topi0 = (LAS int*)(topv0 + 128);
    LAS int* ent_tok = (LAS int*)(lds + 49152);
    LAS int* ent_e = ent_tok + 1024; LAS int* ent_lp = ent_e + 1024; LAS float* ent_w = (LAS float*)(ent_lp + 1024);
    LAS int* lcount = (LAS int*)(ent_w + 1024); LAS int* lbase = lcount + 32; LAS int* nent = lbase + 32;
    ETab T; T.pe = nullptr; T.pbase = nullptr; T.cnt = nullptr;
    if (combine) T = build_etab(lds, wv_, (const unsigned*)(ws + WS_CTL) + CW_CNT);
    if (ROUTER) { if (tid < 32) lcount[tid] = 0; if (tid == 0) nent[0] = 0; }
    __syncthreads();
    const float* wpk = ROUTER ? (const float*)(ws + WS_WRP) + (size_t)layer * DM * 32 : (const float*)(ws + WS_WGP) + (size_t)layer * DM * 16;
    constexpr int NT = ROUTER ? 2 : 1;
    const int kb = wave * 256 + 8 * g;
    const float* xlat = AP(x); const float* xctx = AP(ctx);
    const bf16* xbb = (const bf16*)(ws + WS_XB);
    f32x4 xn[8][2]; u32x4 xr[8]; i32x4 ten = (i32x4){0, 0, 0, 0}, tpn = (i32x4){0, 0, 0, 0};
#define NORM_ISSUE(rg_) do { const int row_ = (rg_) * 16 + r; \
        if (XBF) { const bf16* sb_ = xbb + (size_t)row_ * DM + kb; _Pragma("unroll") for (int s = 0; s < 8; ++s) xr[s] = *(const u32x4*)(sb_ + 32 * s); } \
        else { const float* src_ = (row_ < TL ? xlat + (size_t)row_ * DM : xctx + (size_t)(row_ - TL) * DM) + kb; \
            _Pragma("unroll") for (int s = 0; s < 8; ++s) { xn[s][0] = *(const f32x4*)(src_ + 32 * s); xn[s][1] = *(const f32x4*)(src_ + 32 * s + 4); } } \
        if (combine) { ten = *(const i32x4*)((const int*)(ws + WS_TOKE) + (size_t)row_ * 4); tpn = *(const i32x4*)((const int*)(ws + WS_TOKP) + (size_t)row_ * 4); } } while (0)
    if (!COMBINE && vcu < ngroups) NORM_ISSUE(vcu);
    int par = 0;
    for (int rg = vcu; rg < ngroups; rg += G, par ^= 1) {
        LAS float* part = part0 + par * 128; LAS float* red = red0 + par * 4096; LAS float* logit = logit0 + par * 512;
        const int row = rg * 16 + r;
        const int mb = row < TL ? (row >> 11) : 8;
        if (COMBINE) NORM_ISSUE(rg);
        f32x4 xv[8][2];
#pragma unroll
        for (int s = 0; s < 8; ++s) {
            if (XBF) { xv[s][0] = (f32x4){bflo(xr[s].x), bfhi(xr[s].x), bflo(xr[s].y), bfhi(xr[s].y)}; xv[s][1] = (f32x4){bflo(xr[s].z), bfhi(xr[s].z), bflo(xr[s].w), bfhi(xr[s].w)}; }
            else { xv[s][0] = xn[s][0]; xv[s][1] = xn[s][1]; } }
        const i32x4 te = ten, tp = tpn;
        if (!COMBINE && rg + G < ngroups) NORM_ISSUE(rg + G);
        if (combine) {
            const float* g2 = (const float*)(ws + WS_MOD) + (size_t)mb * MODW + 5 * DM + kb;
            const unsigned char* Y = (const unsigned char*)(ws + WS_Y);
            bf16* xa = (bf16*)(ws + WS_XA) + (size_t)row * DM + kb;
            const unsigned char* y0 = Y + ((size_t)T.pbase[te[0]] * 256 + tp[0]) * DM + kb; const unsigned char* y1 = Y + ((size_t)T.pbase[te[1]] * 256 + tp[1]) * DM + kb;
            const unsigned char* y2 = Y + ((size_t)T.pbase[te[2]] * 256 + tp[2]) * DM + kb; const unsigned char* y3 = Y + ((size_t)T.pbase[te[3]] * 256 + tp[3]) * DM + kb;
            u32x2 ya[8], yb[8], yc[8], yd[8];
#pragma unroll
            for (int s = 0; s < 8; ++s) ya[s] = *(const u32x2*)(y0 + 32 * s);
#pragma unroll
            for (int s = 0; s < 8; ++s) yb[s] = *(const u32x2*)(y1 + 32 * s);
#pragma unroll
            for (int s = 0; s < 8; ++s) yc[s] = *(const u32x2*)(y2 + 32 * s);
#pragma unroll
            for (int s = 0; s < 8; ++s) yd[s] = *(const u32x2*)(y3 + 32 * s);
#pragma unroll
            for (int s = 0; s < 8; ++s) {
                const f32x4 s0 = ((up4_fp8(ya[s].x) + up4_fp8(yb[s].x)) + (up4_fp8(yc[s].x) + up4_fp8(yd[s].x))) * Y8I;
                const f32x4 s1 = ((up4_fp8(ya[s].y) + up4_fp8(yb[s].y)) + (up4_fp8(yc[s].y) + up4_fp8(yd[s].y))) * Y8I;
                xv[s][0] = xv[s][0] + *(const f32x4*)(g2 + 32 * s) * s0;
                xv[s][1] = xv[s][1] + *(const f32x4*)(g2 + 32 * s + 4) * s1;
                { u32x4 pk; pk.x = cvt_pk_bf16(xv[s][0][0], xv[s][0][1]); pk.y = cvt_pk_bf16(xv[s][0][2], xv[s][0][3]); pk.z = cvt_pk_bf16(xv[s][1][0], xv[s][1][1]); pk.w = cvt_pk_bf16(xv[s][1][2], xv[s][1][3]); *(u32x4*)(xa + 32 * s) = pk; }
            }
        }
        float ss = 0.f;
#pragma unroll
        for (int s = 0; s < 8; ++s)
#pragma unroll
            for (int h = 0; h < 2; ++h) ss += (xv[s][h][0] * xv[s][h][0] + xv[s][h][1] * xv[s][h][1]) + (xv[s][h][2] * xv[s][h][2] + xv[s][h][3] * xv[s][h][3]);
        ss += shx(ss, 16, lane); ss += shx(ss, 32, lane);
        if (g == 0) part[wave * 16 + r] = ss;
        __syncthreads();
        float tot = 0.f;
#pragma unroll
        for (int w = 0; w < 8; ++w) tot += part[w * 16 + r];
        const float rstd = rsqrtf(tot * (1.0f / DM) + EPS);
        const float* msh = MOD + (size_t)mb * MODW + off_sh + kb; const float* msc = MOD + (size_t)mb * MODW + off_sc + kb; const float* nwp = nw + kb;
#pragma unroll
        for (int s = 0; s < 8; ++s) {
#pragma unroll
            for (int h = 0; h < 2; ++h) {
                const f32x4 wv = *(const f32x4*)(nwp + 32 * s + 4 * h), scv = *(const f32x4*)(msc + 32 * s + 4 * h), shv = *(const f32x4*)(msh + 32 * s + 4 * h);
                xv[s][h] = xv[s][h] * rstd * wv * (scv + 1.0f) + shv;
            }
            { u32x2 pk; pk.x = pk4_fp8(xv[s][0][0], xv[s][0][1], xv[s][0][2], xv[s][0][3]); pk.y = pk4_fp8(xv[s][1][0], xv[s][1][1], xv[s][1][2], xv[s][1][3]);
                *(u32x2*)((unsigned char*)(ws + WS_HX) + (size_t)row * DM + kb + 32 * s) = pk; }
            if ((s & 1) == 1) asm volatile("" ::: "memory");
        }
        bf16x8 xh[8], xl[8];
#pragma unroll
        for (int s = 0; s < 8; ++s) {
            u32x4 hw, lw;
            hw.x = cvt_pk_bf16(xv[s][0][0], xv[s][0][1]); hw.y = cvt_pk_bf16(xv[s][0][2], xv[s][0][3]); hw.z = cvt_pk_bf16(xv[s][1][0], xv[s][1][1]); hw.w = cvt_pk_bf16(xv[s][1][2], xv[s][1][3]);
            lw.x = cvt_pk_bf16(xv[s][0][0] - bflo(hw.x), xv[s][0][1] - bfhi(hw.x)); lw.y = cvt_pk_bf16(xv[s][0][2] - bflo(hw.y), xv[s][0][3] - bfhi(hw.y));
            lw.z = cvt_pk_bf16(xv[s][1][0] - bflo(hw.z), xv[s][1][1] - bfhi(hw.z)); lw.w = cvt_pk_bf16(xv[s][1][2] - bflo(hw.w), xv[s][1][3] - bfhi(hw.w));
            xh[s] = __builtin_bit_cast(bf16x8, hw); xl[s] = __builtin_bit_cast(bf16x8, lw);
        }
        f32x4 acc[NT];
#pragma unroll
        for (int t = 0; t < NT; ++t) acc[t] = (f32x4){0.f, 0.f, 0.f, 0.f};
        {
            f32x4 bw[2][4][2];
#define NORM_BLOAD(buf_, b_) do { _Pragma("unroll") for (int s = 0; s < 4; ++s) { const float* bp = wpk + ((((size_t)(wave * 8 + 4 * ((b_) & 1) + s) * 4 + g) * NT + ((b_) >> 1)) * 16 + r) * 8; \
                bw[buf_][s][0] = *(const f32x4*)bp; bw[buf_][s][1] = *(const f32x4*)(bp + 4); } } while (0)
            NORM_BLOAD(0, 0);
#pragma unroll
            for (int bb = 0; bb < 2 * NT; ++bb) {
                const int t = bb >> 1, sh = bb & 1, cu = bb & 1;
                if (bb + 1 < 2 * NT) NORM_BLOAD(cu ^ 1, bb + 1);
#pragma unroll
                for (int s = 0; s < 4; ++s) {
                    u32x4 hw, lw;
                    hw.x = cvt_pk_bf16(bw[cu][s][0][0], bw[cu][s][0][1]); hw.y = cvt_pk_bf16(bw[cu][s][0][2], bw[cu][s][0][3]); hw.z = cvt_pk_bf16(bw[cu][s][1][0], bw[cu][s][1][1]); hw.w = cvt_pk_bf16(bw[cu][s][1][2], bw[cu][s][1][3]);
                    lw.x = cvt_pk_bf16(bw[cu][s][0][0] - bflo(hw.x), bw[cu][s][0][1] - bfhi(hw.x)); lw.y = cvt_pk_bf16(bw[cu][s][0][2] - bflo(hw.y), bw[cu][s][0][3] - bfhi(hw.y));
                    lw.z = cvt_pk_bf16(bw[cu][s][1][0] - bflo(hw.z), bw[cu][s][1][1] - bfhi(hw.z)); lw.w = cvt_pk_bf16(bw[cu][s][1][2] - bflo(hw.w), bw[cu][s][1][3] - bfhi(hw.w));
                    const bf16x8 wh = __builtin_bit_cast(bf16x8, hw), wl = __builtin_bit_cast(bf16x8, lw);
                    acc[t] = __builtin_amdgcn_mfma_f32_16x16x32_bf16(xl[4 * sh + s], wh, acc[t], 0, 0, 0);
                    acc[t] = __builtin_amdgcn_mfma_f32_16x16x32_bf16(xh[4 * sh + s], wl, acc[t], 0, 0, 0);
                    acc[t] = __builtin_amdgcn_mfma_f32_16x16x32_bf16(xh[4 * sh + s], wh, acc[t], 0, 0, 0);
                }
                asm volatile("" ::: "memory");
            }
#undef NORM_BLOAD
        }
#pragma unroll
        for (int t = 0; t < NT; ++t)
#pragma unroll
            for (int q = 0; q < 4; ++q) red[wave * 512 + (4 * g + q) * 32 + 16 * t + r] = acc[t][q];
        __syncthreads();
        if (!ROUTER) {
            if (tid < 256) {
                const int rr = tid >> 4, j = tid & 15; float v = 0.f;
#pragma unroll
                for (int w = 0; w < 8; ++w) v += red[w * 512 + rr * 32 + j];
                v += AP(b_gates)[layer * 16 + j];
                const float z = v * (1.0f / 15.0f);
                v = 15.0f * (1.0f - 2.0f / (__expf(2.0f * z) + 1.0f));
                ((float*)(ws + WS_GATES))[(size_t)(rg * 16 + rr) * 16 + j] = v;
            }
        } else {
            LAS float* topv = topv0 + par * 64; LAS int* topi = topi0 + par * 64;
            const int rr = tid >> 5, j = tid & 31; float v = 0.f;
#pragma unroll
            for (int w = 0; w < 8; ++w) v += red[w * 512 + rr * 32 + j];
            v += AP(b_router)[layer * NEXP + j];
            logit[rr * 32 + j] = v;
            __syncthreads();
            int rank = 0;
#pragma unroll 8
            for (int e = 0; e < NEXP; ++e) { const float o = logit[rr * 32 + e]; rank += (o > v || (o == v && e < j)) ? 1 : 0; }
            if (rank < 4) { topv[rr * 4 + rank] = v; topi[rr * 4 + rank] = j; }
            __syncthreads();
            if (tid < 64) {
                const int row2 = tid >> 2, k = tid & 3, tok = rg * 16 + row2;
                const float v0 = topv[row2 * 4 + 0], e1 = __expf(topv[row2 * 4 + 1] - v0), e2 = __expf(topv[row2 * 4 + 2] - v0), e3 = __expf(topv[row2 * 4 + 3] - v0);
                const float mine = __expf(topv[row2 * 4 + k] - v0), inv = 1.0f / (1.0f + e1 + e2 + e3);
                const int e = topi[row2 * 4 + k];
                const int base = atomicAdd((int*)nent, 1);
                const int lp = atomicAdd((int*)&lcount[e], 1);
                ent_tok[base] = tok * 4 + k; ent_e[base] = e; ent_lp[base] = lp; ent_w[base] = mine * inv;
            }
        }
    }
#undef NORM_ISSUE
    if (ROUTER) {
        __syncthreads();
        unsigned* gcnt = (unsigned*)(ws + WS_CTL) + CW_CNT + 32 * layer;
        if (tid < 32) lbase[tid] = (int)atomicAdd(&gcnt[tid], (unsigned)lcount[tid]);
        __syncthreads();
        const int n = nent[0];
        for (int i = tid; i < n; i += 512) {
            const int e = ent_e[i], pos = lbase[e] + ent_lp[i], tk = ent_tok[i];
            ((int*)(ws + WS_IDXL))[(size_t)e * TT + pos] = tk >> 2;
            ((float*)(ws + WS_WL))[(size_t)e * TT + pos] = ent_w[i];
            ((int*)(ws + WS_TOKE))[tk] = e; ((int*)(ws + WS_TOKP))[tk] = pos;
        }
    }
    __syncthreads();
}

typedef short v4i16_t __attribute__((ext_vector_type(4)));
__device__ __forceinline__ u32x2 trr(const LAS bf16* p) { return __builtin_bit_cast(u32x2, __builtin_amdgcn_ds_read_tr16_b64_v4i16((LAS v4i16_t*)p)); }
__device__ __forceinline__ bf16x8 cat8(u32x2 lo, u32x2 hi) { u32x4 w; w.x = lo.x; w.y = lo.y; w.z = hi.x; w.w = hi.y; return __builtin_bit_cast(bf16x8, w); }

__device__ __forceinline__ void attn_unit(LAS unsigned char* lds, int wv_, int layer, int b, int nblk, int half, int kvh) {
    const int tid = otid(wv_), lane = tid & 63, wave = __builtin_amdgcn_readfirstlane(tid >> 6), qi = lane & 15, gq = lane >> 4;
    unsigned char* ws = ((unsigned char*)AP(ws));
    const bf16* PR = (const bf16*)(ws + WS_PR);
    unsigned char* CAT = (unsigned char*)(ws + WS_CAT);
    LAS bf16* Lq = (LAS bf16*)(lds + 40960);
    const bool isctx = nblk < 0;
    const int qrow0 = isctx ? TL + b * CTXL + half * 128 : b * SEQ + nblk * 128;
    const int hq = kvh * 4 + (wave >> 1), qoff = (wave & 1) * 64;
    const int nloc = isctx ? 0 : 3 - (nblk == 0 ? 1 : 0) - (nblk == SEQ / 128 - 1 ? 1 : 0), j0 = (!isctx && nblk == 0) ? 1 : 0, ntile = nloc + 2;
#define T_ROW(ti_) ((ti_) < nloc ? b * SEQ + (nblk - 1 + j0 + (ti_)) * 128 : TL + b * CTXL + ((ti_) - nloc) * 128)
#define T_TL(ti_) ((ti_) < nloc ? j0 + (ti_) : 1)
    u32x4 rk[2], rv[2];
#define AT_LOAD(krow0_) do { _Pragma("unroll") for (int j = 0; j < 2; ++j) { const int cid = tid + 512 * j, key = cid >> 3, c = cid & 7; \
        rk[j] = *(const u32x4*)(PR + (size_t)((krow0_) + key) * DINM + 1024 + kvh * 64 + 8 * c); rv[j] = *(const u32x4*)(PR + (size_t)((krow0_) + key) * DINM + 1280 + kvh * 64 + 8 * c); } } while (0)
    AT_LOAD(T_ROW(0));
    __syncthreads();
#pragma unroll
    for (int j = 0; j < 8; ++j) {
        const int cid = tid + 512 * j, rowi = cid >> 3, c = cid & 7, hh = rowi >> 7, qr = rowi & 127;
        *(LAS u32x4*)(Lq + rowi * 72 + 8 * c) = *(const u32x4*)(PR + (size_t)(qrow0 + qr) * DINM + (kvh * 4 + hh) * 64 + 8 * c);
    }
    const float sinkv = AP(attn_sink)[layer * 16 + hq] * LOG2E;
    float mrun[4], lsum[4]; f32x4 o[4][4]; const f32x4 zq = zero4();
#pragma unroll
    for (int qt = 0; qt < 4; ++qt) { mrun[qt] = sinkv; lsum[qt] = 1.0f;
#pragma unroll
        for (int dt = 0; dt < 4; ++dt) o[qt][dt] = zq; }
#define AT_STAGE(set_) do { LAS bf16* Kw_ = (LAS bf16*)(lds + ((set_) ? 114688 : 0)); LAS bf16* Vw_ = Kw_ + 10240; \
        _Pragma("unroll") for (int j = 0; j < 2; ++j) { const int cid = tid + 512 * j, key = cid >> 3, c = cid & 7; *(LAS u32x4*)(Kw_ + key * 80 + 8 * c) = rk[j]; *(LAS u32x4*)(Vw_ + key * 80 + 8 * c) = rv[j]; } } while (0)
    AT_STAGE(0);
    if (ntile > 1) AT_LOAD(T_ROW(1));
    LDS_WAIT();
    __syncthreads();
#pragma unroll 1
    for (int ti = 0; ti < ntile; ++ti) {
        const int tl = T_TL(ti), cur = ti & 1;
        const LAS bf16* Kt = (const LAS bf16*)(lds + (cur ? 114688 : 0)); const LAS bf16* Vt = Kt + 10240;
        if (ti + 1 < ntile) { AT_STAGE(cur ^ 1); if (ti + 2 < ntile) AT_LOAD(T_ROW(ti + 2)); }
#pragma unroll
        for (int qp = 0; qp < 2; ++qp) {
            bf16x8 qb[2][2];
#pragma unroll
            for (int u = 0; u < 2; ++u)
#pragma unroll
                for (int kk = 0; kk < 2; ++kk) qb[u][kk] = *(const LAS bf16x8*)(Lq + ((wave >> 1) * 128 + qoff + 16 * (2 * qp + u) + qi) * 72 + 32 * kk + 8 * gq);
            f32x4 s[2][8];
            __builtin_amdgcn_s_setprio(1);
#pragma unroll
            for (int kt = 0; kt < 8; ++kt) {
                const bf16x8 ka0 = *(const LAS bf16x8*)(Kt + (16 * kt + qi) * 80 + 8 * gq), ka1 = *(const LAS bf16x8*)(Kt + (16 * kt + qi) * 80 + 32 + 8 * gq);
#pragma unroll
                for (int u = 0; u < 2; ++u) {
                    s[u][kt] = __builtin_amdgcn_mfma_f32_16x16x32_bf16(ka0, qb[u][0], (f32x4){0.f, 0.f, 0.f, 0.f}, 0, 0, 0);
                    s[u][kt] = __builtin_amdgcn_mfma_f32_16x16x32_bf16(ka1, qb[u][1], s[u][kt], 0, 0, 0);
                }
            }
            __builtin_amdgcn_s_setprio(0);
            if (tl != 1) {
                const int sgn = (tl == 0) ? 1 : -1;
#pragma unroll
                for (int u = 0; u < 2; ++u) {
                    const int dbase = 4 * gq - (qoff + 16 * (2 * qp + u) + qi);
#pragma unroll
                    for (int kt = 0; kt < 8; ++kt)
#pragma unroll
                        for (int rr = 0; rr < 4; ++rr) { const int d = sgn * (dbase + 16 * kt + rr); s[u][kt][rr] += __int_as_float((d >> 31) & (int)0xF149F2CAu); }
                }
            }
            float alpha[2];
#pragma unroll
            for (int u = 0; u < 2; ++u) {
                const int qt = 2 * qp + u;
                float mx = -1.0e30f;
#pragma unroll
                for (int kt = 0; kt < 8; ++kt) mx = fmaxf(fmaxf(mx, fmaxf(s[u][kt][0], s[u][kt][1])), fmaxf(s[u][kt][2], s[u][kt][3]));
                mx = fmaxf(mx, shx(mx, 16, lane)); mx = fmaxf(mx, shx(mx, 32, lane));
                const float mnew = fmaxf(mrun[qt], mx);
                alpha[u] = __builtin_amdgcn_exp2f(mrun[qt] - mnew);
                float rs = 0.f;
#pragma unroll
                for (int kt = 0; kt < 8; ++kt)
#pragma unroll
                    for (int rr = 0; rr < 4; ++rr) { const float p = __builtin_amdgcn_exp2f(s[u][kt][rr] - mnew); s[u][kt][rr] = p; rs += p; }
                rs += shx(rs, 16, lane); rs += shx(rs, 32, lane);
                lsum[qt] = lsum[qt] * alpha[u] + rs; mrun[qt] = mnew;
#pragma unroll
                for (int dt = 0; dt < 4; ++dt) o[qt][dt] = o[qt][dt] * alpha[u];
            }
            __builtin_amdgcn_s_setprio(1);
#pragma unroll
            for (int k2 = 0; k2 < 4; ++k2) {
                bf16x8 pb[2];
#pragma unroll
                for (int u = 0; u < 2; ++u) {
                    u32x4 pw; pw.x = cvt_pk_bf16(s[u][2 * k2][0], s[u][2 * k2][1]); pw.y = cvt_pk_bf16(s[u][2 * k2][2], s[u][2 * k2][3]); pw.z = cvt_pk_bf16(s[u][2 * k2 + 1][0], s[u][2 * k2 + 1][1]); pw.w = cvt_pk_bf16(s[u][2 * k2 + 1][2], s[u][2 * k2 + 1][3]);
                    pb[u] = __builtin_bit_cast(bf16x8, pw);
                }
#pragma unroll
                for (int dt = 0; dt < 4; ++dt) {
                    const LAS bf16* vp = Vt + (32 * k2 + 4 * gq + (qi >> 2)) * 80 + 16 * dt + 4 * (qi & 3);
                    const bf16x8 vf = cat8(trr(vp), trr(vp + 16 * 80));
                    o[2 * qp][dt] = __builtin_amdgcn_mfma_f32_16x16x32_bf16(vf, pb[0], o[2 * qp][dt], 0, 0, 0);
                    o[2 * qp + 1][dt] = __builtin_amdgcn_mfma_f32_16x16x32_bf16(vf, pb[1], o[2 * qp + 1][dt], 0, 0, 0);
                }
            }
            __builtin_amdgcn_s_setprio(0);
        }
        if (ti + 1 < ntile) { LDS_WAIT(); __syncthreads(); }
    }
#undef AT_STAGE
#undef AT_LOAD
#undef T_ROW
#undef T_TL
#pragma unroll
    for (int qt = 0; qt < 4; ++qt) {
        const float inv = 1.0f / lsum[qt];
        LAS unsigned char* st = (LAS unsigned char*)(Lq + ((wave >> 1) * 128 + qoff + 16 * qt + qi) * 72);
#pragma unroll
        for (int dt = 0; dt < 4; ++dt) { const f32x4 ov = o[qt][dt] * (inv * C8S); *(LAS unsigned*)(st + 16 * dt + 4 * gq) = pk4_fp8(clamp8(ov[0]), clamp8(ov[1]), clamp8(ov[2]), clamp8(ov[3])); }
    }
#pragma unroll
    for (int qt = 0; qt < 4; ++qt) {
        const LAS unsigned char* st = (const LAS unsigned char*)(Lq + ((wave >> 1) * 128 + qoff + 16 * qt + qi) * 72);
        *(u32x4*)(CAT + (size_t)(qrow0 + qoff + 16 * qt + qi) * DM + hq * 64 + 16 * gq) = *(const LAS u32x4*)(st + 16 * gq);
    }
}

__device__ __forceinline__ void mlstm_item(LAS unsigned char* lds, int wv_, int layer, int item) {
    const int tid = otid(wv_), lane = tid & 63, wave = __builtin_amdgcn_readfirstlane(tid >> 6), li = lane & 15, g = lane >> 4;
    const int vs = item & 3, dir = (item >> 2) & 1, h = (item >> 3) & 3, b = item >> 5;
    unsigned char* ws = ((unsigned char*)AP(ws));
    const bf16* PR = (const bf16*)(ws + WS_PR);
    const float* GATES = (const float*)(ws + WS_GATES);
    bf16* HO = (bf16*)(ws + (dir ? WS_HB : WS_HF));
    float* GS = (float*)(ws + WS_GS) + (size_t)item * 18 * 384;
    constexpr int P = 144, PV = 80, PC = 72;
    LAS bf16* Lq = (LAS bf16*)lds;
    LAS bf16* Lk = (LAS bf16*)(lds + 36864);
    LAS bf16* Lkw = (LAS bf16*)(lds + 73728);
    LAS bf16* Lv = (LAS bf16*)(lds + 110592);
    LAS bf16* LCt = (LAS bf16*)(lds + 131072);
    LAS float* A_b = (LAS float*)(lds + 149504);
    LAS float* A_a = A_b + 128; LAS float* A_cm = A_a + 128; LAS float* A_n = A_cm + 128;
    auto chunk_base = [&](int ci) -> int { return ci < 2 ? TL + b * CTXL + (dir == 0 ? ci : 1 - ci) * 128 : b * SEQ + (dir == 0 ? ci - 2 : 17 - ci) * 128; };
    __syncthreads();
    for (int ci = wave; ci < 18; ci += 8) {
        const int base = chunk_base(ci);
        float lsf[2], ig[2];
#pragma unroll
        for (int j = 0; j < 2; ++j) {
            const int tau = 2 * lane + j, row = base + (dir == 0 ? tau : 127 - tau);
            ig[j] = GATES[(size_t)row * 16 + dir * 8 + h]; const float fg = GATES[(size_t)row * 16 + dir * 8 + 4 + h];
            lsf[j] = fminf(fg, 0.f) - log1pf(__expf(-fabsf(fg)));
        }
        float sc = lsf[0] + lsf[1];
#pragma unroll
        for (int off = 1; off < 64; off <<= 1) { const float t = shup(sc, off, lane); if (lane >= off) sc += t; }
        const float b0 = (sc - (lsf[0] + lsf[1])) + lsf[0], b1 = b0 + lsf[1];
        const float a0 = ig[0] - b0, a1 = ig[1] - b1;
        float mm = fmaxf(a0, a1);
#pragma unroll
        for (int off = 1; off < 64; off <<= 1) { const float t = shup(mm, off, lane); if (lane >= off) mm = fmaxf(mm, t); }
        float mex = shup(mm, 1, lane); if (lane == 0) mex = -3.0e38f;
        const float c0 = fmaxf(mex, a0), c1 = fmaxf(c0, a1);
        float* gs = GS + ci * 384 + 2 * lane;
        *(f32x2*)(gs) = (f32x2){b0, b1}; *(f32x2*)(gs + 128) = (f32x2){a0, a1}; *(f32x2*)(gs + 256) = (f32x2){c0, c1};
    }
    if (tid < 128) A_n[tid] = 0.f;
    VM_WAIT();
    __syncthreads();
    u32x4 rq[4], rk[4], rv[2]; float rg = 0.f, r_bl, r_cl, ra[4];
#define ML_LOAD(ci_) do { const int base_ = chunk_base(ci_); \
        _Pragma("unroll") for (int j = 0; j < 4; ++j) { const int cid = tid + 512 * j, tau = cid >> 4, c = cid & 15; const size_t ro = (size_t)(base_ + (dir == 0 ? tau : 127 - tau)) * DINM; \
            rq[j] = *(const u32x4*)(PR + ro + 1536 + h * 128 + 8 * c); rk[j] = *(const u32x4*)(PR + ro + 2048 + h * 128 + 8 * c); } \
        _Pragma("unroll") for (int j = 0; j < 2; ++j) { const int cid = tid + 512 * j, tau = cid >> 3, c = cid & 7; const size_t ro = (size_t)(base_ + (dir == 0 ? tau : 127 - tau)) * DINM; \
            rv[j] = *(const u32x4*)(PR + ro + 2560 + h * 256 + vs * 64 + 8 * c); } \
        _Pragma("unroll") for (int j = 0; j < 4; ++j) ra[j] = GS[(ci_) * 384 + 128 + ((tid + 512 * j) >> 4)]; \
        if (tid < 384) rg = GS[(ci_) * 384 + tid]; r_bl = GS[(ci_) * 384 + 127]; r_cl = GS[(ci_) * 384 + 383]; } while (0)
    ML_LOAD(0);
    float m = 0.f, wcar_prev = 0.f, npart = 0.f;
    f32x4 Cacc[4]; const f32x4 zq = zero4();
#pragma unroll
    for (int vt = 0; vt < 4; ++vt) Cacc[vt] = zq;
    for (int ci = 0; ci < 18; ++ci) {
        const int base = chunk_base(ci);
        const float mprev = m, blast = r_bl, mnew = blast + fmaxf(mprev, r_cl), wcar = __expf(blast + mprev - mnew);
        __syncthreads();
        if (ci > 0 && g == 0) A_n[16 * wave + li] = wcar_prev * A_n[16 * wave + li] + npart;
        if (tid < 384) A_b[tid] = rg;
#pragma unroll
        for (int j = 0; j < 4; ++j) {
            const int cid = tid + 512 * j, tau = cid >> 4, c = cid & 15;
            *(LAS u32x4*)(Lq + tau * P + 8 * c) = rq[j];
            *(LAS u32x4*)(Lk + tau * P + 8 * c) = rk[j];
        }
#pragma unroll
        for (int j = 0; j < 2; ++j) { const int cid = tid + 512 * j, tau = cid >> 3, c = cid & 7; *(LAS u32x4*)(Lv + tau * PV + 8 * c) = rv[j]; }
#pragma unroll
        for (int vt = 0; vt < 4; ++vt) { u32x2 cw; cw.x = cvt_pk_bf16(Cacc[vt][0], Cacc[vt][1]); cw.y = cvt_pk_bf16(Cacc[vt][2], Cacc[vt][3]); *(LAS u32x2*)(LCt + (16 * wave + li) * PC + 16 * vt + 4 * g) = cw; }
#pragma unroll
        for (int j = 0; j < 4; ++j) {
            const int cid = tid + 512 * j, tau = cid >> 4, c = cid & 15;
            const float wsv = __expf(blast + ra[j] - mnew);
            const u32x4 kv = rk[j]; u32x4 kw;
            kw.x = cvt_pk_bf16(bflo(kv.x) * wsv, bfhi(kv.x) * wsv); kw.y = cvt_pk_bf16(bflo(kv.y) * wsv, bfhi(kv.y) * wsv); kw.z = cvt_pk_bf16(bflo(kv.z) * wsv, bfhi(kv.z) * wsv); kw.w = cvt_pk_bf16(bflo(kv.w) * wsv, bfhi(kv.w) * wsv);
            *(LAS u32x4*)(Lkw + tau * P + 8 * c) = kw;
        }
        if (ci + 1 < 18) ML_LOAD(ci + 1);
        LDS_WAIT();
        __syncthreads();
        bf16x8 qa[4];
#pragma unroll
        for (int kk = 0; kk < 4; ++kk) qa[kk] = *(const LAS bf16x8*)(Lq + (16 * wave + li) * P + 32 * kk + 8 * g);
        __builtin_amdgcn_s_setprio(1);
        f32x4 sT[8];
#pragma unroll
        for (int kk = 0; kk < 4; ++kk)
#pragma unroll
            for (int st = 0; st < 8; ++st) {
                const bf16x8 kb = *(const LAS bf16x8*)(Lk + (16 * st + li) * P + 32 * kk + 8 * g);
                sT[st] = __builtin_amdgcn_mfma_f32_16x16x32_bf16(kb, qa[kk], kk == 0 ? (f32x4){0.f, 0.f, 0.f, 0.f} : sT[st], 0, 0, 0);
            }
        f32x4 hT[4];
#pragma unroll
        for (int kk = 0; kk < 4; ++kk)
#pragma unroll
            for (int vt = 0; vt < 4; ++vt) {
                const LAS bf16* cp = LCt + (32 * kk + 8 * g + (li >> 2)) * PC + 16 * vt + 4 * (li & 3);
                hT[vt] = __builtin_amdgcn_mfma_f32_16x16x32_bf16(cat8(trr(cp), trr(cp + 4 * PC)), qa[kk], kk == 0 ? (f32x4){0.f, 0.f, 0.f, 0.f} : hT[vt], 0, 0, 0);
            }
        __builtin_amdgcn_s_setprio(0);
        float nq = 0.f;
#pragma unroll
        for (int kk = 0; kk < 4; ++kk) {
            const u32x4 qw = __builtin_bit_cast(u32x4, qa[kk]);
            const f32x4 n0 = *(const LAS f32x4*)(A_n + 32 * kk + 8 * g), n1 = *(const LAS f32x4*)(A_n + 32 * kk + 8 * g + 4);
            nq += bflo(qw.x) * n0[0] + bfhi(qw.x) * n0[1] + bflo(qw.y) * n0[2] + bfhi(qw.y) * n0[3] + bflo(qw.z) * n1[0] + bfhi(qw.z) * n1[1] + bflo(qw.w) * n1[2] + bfhi(qw.w) * n1[3];
        }
        nq += shx(nq, 16, lane); nq += shx(nq, 32, lane);
        const float bt = A_b[16 * wave + li], mtt = bt + fmaxf(mprev, A_cm[16 * wave + li]), wint = __expf(bt + mprev - mtt);
        float rs = 0.f;
        {
            const int dbase = 4 * g - li - 16 * wave;
            const float bm = bt - mtt;
#pragma unroll
            for (int st = 0; st < 8; ++st) {
                const f32x4 a4 = *(const LAS f32x4*)(A_a + 16 * st + 4 * g);
#pragma unroll
                for (int r = 0; r < 4; ++r) {
                    const float arg = (dbase + 16 * st + r <= 0) ? (bm + a4[r]) : -1.0e30f;
                    const float p = sT[st][r] * __expf(arg);
                    sT[st][r] = p; rs += p;
                }
            }
        }
        rs += shx(rs, 16, lane); rs += shx(rs, 32, lane);
        const float hden = 1.0f / fmaxf(fabsf(rs + wint * nq), __expf(-mtt));
#pragma unroll
        for (int vt = 0; vt < 4; ++vt) { hT[vt] = hT[vt] * wint; Cacc[vt] = Cacc[vt] * wcar; }
        {
            __builtin_amdgcn_s_setprio(1);
            bf16x8 kf[4];
#pragma unroll
            for (int kk = 0; kk < 4; ++kk) { const LAS bf16* kp = Lkw + (32 * kk + 4 * g + (li >> 2)) * P + 16 * wave + 4 * (li & 3); kf[kk] = cat8(trr(kp), trr(kp + 16 * P)); }
#pragma unroll
            for (int kk = 0; kk < 4; ++kk) {
                u32x4 pw; pw.x = cvt_pk_bf16(sT[2 * kk][0], sT[2 * kk][1]); pw.y = cvt_pk_bf16(sT[2 * kk][2], sT[2 * kk][3]); pw.z = cvt_pk_bf16(sT[2 * kk + 1][0], sT[2 * kk + 1][1]); pw.w = cvt_pk_bf16(sT[2 * kk + 1][2], sT[2 * kk + 1][3]);
                const bf16x8 pb = __builtin_bit_cast(bf16x8, pw);
#pragma unroll
                for (int vt = 0; vt < 4; ++vt) {
                    const LAS bf16* vp = Lv + (32 * kk + 4 * g + (li >> 2)) * PV + 16 * vt + 4 * (li & 3);
                    const bf16x8 vf = cat8(trr(vp), trr(vp + 16 * PV));
                    hT[vt] = __builtin_amdgcn_mfma_f32_16x16x32_bf16(vf, pb, hT[vt], 0, 0, 0);
                    Cacc[vt] = __builtin_amdgcn_mfma_f32_16x16x32_bf16(vf, kf[kk], Cacc[vt], 0, 0, 0);
                }
            }
            u32x4 on; on.x = 0x3f803f80u; on.y = 0x3f803f80u; on.z = 0x3f803f80u; on.w = 0x3f803f80u;
            f32x4 nacc = __builtin_amdgcn_mfma_f32_16x16x32_bf16(__builtin_bit_cast(bf16x8, on), kf[0], (f32x4){0.f, 0.f, 0.f, 0.f}, 0, 0, 0);
#pragma unroll
            for (int kk = 1; kk < 4; ++kk) nacc = __builtin_amdgcn_mfma_f32_16x16x32_bf16(__builtin_bit_cast(bf16x8, on), kf[kk], nacc, 0, 0, 0);
            npart = nacc[0];
            __builtin_amdgcn_s_setprio(0);
        }
        if (!(layer == 1 && ci < 2)) {
            LAS bf16* Hs = Lq + (16 * wave) * P;
#pragma unroll
            for (int vt = 0; vt < 4; ++vt) { u32x2 hw; hw.x = cvt_pk_bf16(hT[vt][0] * hden, hT[vt][1] * hden); hw.y = cvt_pk_bf16(hT[vt][2] * hden, hT[vt][3] * hden); *(LAS u32x2*)(Hs + li * P + 16 * vt + 4 * g) = hw; }
#pragma unroll
            for (int j = 0; j < 2; ++j) {
                const int cid = lane + 64 * j, tr = cid >> 3, c = cid & 7, t = 16 * wave + tr, row = base + (dir == 0 ? t : 127 - t);
                *(u32x4*)(HO + (size_t)row * 1024 + h * 256 + vs * 64 + 8 * c) = *(const LAS u32x4*)(Hs + tr * P + 8 * c);
            }
        }
        m = mnew; wcar_prev = wcar;
    }
#undef ML_LOAD
    __syncthreads();
}

__device__ __forceinline__ void phase_mlcomb(LAS unsigned char* lds, int wv_, int layer, int vcu, int G) {
    const int tid = otid(wv_), lane = tid & 63, wave = tid >> 6;
    const int nrows = layer == 0 ? TT : TL;
    unsigned char* ws = ((unsigned char*)AP(ws));
    const bf16* HF = (const bf16*)(ws + WS_HF); const bf16* HB = (const bf16*)(ws + WS_HB); const bf16* PR = (const bf16*)(ws + WS_PR);
    unsigned char* CAT = (unsigned char*)(ws + WS_CAT);
    const float* mnw = AP(mlstm_norm_w) + (size_t)layer * 1024;
    for (int it = vcu * 8 + wave; it < nrows * 4; it += G * 8) {
        const int row = it >> 2, h = it & 3, col = h * 256 + 4 * lane;
        const u32x2 f = *(const u32x2*)(HF + (size_t)row * 1024 + col), bb = *(const u32x2*)(HB + (size_t)row * 1024 + col), oo = *(const u32x2*)(PR + (size_t)row * DINM + 3584 + col);
        f32x4 s = (f32x4){bflo(f.x) + bflo(bb.x), bfhi(f.x) + bfhi(bb.x), bflo(f.y) + bflo(bb.y), bfhi(f.y) + bfhi(bb.y)};
        float ss = (s[0] * s[0] + s[1] * s[1]) + (s[2] * s[2] + s[3] * s[3]);
#pragma unroll
        for (int o = 1; o < 64; o <<= 1) ss += shx(ss, o, lane);
        const float rstd = rsqrtf(ss * (1.0f / 256.0f) + EPS);
        const f32x4 w = *(const f32x4*)(mnw + col);
        const f32x4 og = (f32x4){sigmoidf_(bflo(oo.x)), sigmoidf_(bfhi(oo.x)), sigmoidf_(bflo(oo.y)), sigmoidf_(bfhi(oo.y))};
        const f32x4 y = s * (rstd * C8S) * w * og;
        *(unsigned*)(CAT + (size_t)row * DM + 1024 + col) = pk4_fp8(clamp8(y[0]), clamp8(y[1]), clamp8(y[2]), clamp8(y[3]));
    }
}

__device__ __forceinline__ void phase_final(LAS unsigned char* lds, int wv_, int vcu, int G) {
    const int tid = otid(wv_), lane = tid & 63, wave = tid >> 6;
    unsigned char* ws = ((unsigned char*)AP(ws));
    const ETab T = build_etab(lds, wv_, (const unsigned*)(ws + WS_CTL) + CW_CNT + 32);
    const unsigned char* Y = (const unsigned char*)(ws + WS_Y);
    for (int row = vcu * 8 + wave; row < TL; row += G * 8) {
        const i32x4 te = *(const i32x4*)((const int*)(ws + WS_TOKE) + (size_t)row * 4), tp = *(const i32x4*)((const int*)(ws + WS_TOKP) + (size_t)row * 4);
        const float* g2 = (const float*)(ws + WS_MOD) + ((size_t)9 + (row >> 11)) * MODW + 5 * DM;
        size_t so[4];
#pragma unroll
        for (int k = 0; k < 4; ++k) so[k] = ((size_t)T.pbase[te[k]] * 256 + tp[k]) * DM;
        const bf16* xb = (const bf16*)(ws + WS_XB) + (size_t)row * DM;
        float* op = ((float*)AP(out)) + (size_t)row * DM;
#pragma unroll
        for (int j = 0; j < 8; ++j) {
            const int col = 4 * lane + 256 * j;
            f32x4 sum = zero4();
#pragma unroll
            for (int k = 0; k < 4; ++k) sum += up4_fp8(*(const unsigned*)(Y + so[k] + col));
            const u32x2 xw = *(const u32x2*)(xb + col);
            *(f32x4*)(op + col) = (f32x4){bflo(xw.x), bfhi(xw.x), bflo(xw.y), bfhi(xw.y)} + *(const f32x4*)(g2 + col) * (sum * Y8I);
        }
    }
}

constexpr int NPH = 18;
template <unsigned PMASK>
__global__ void __launch_bounds__(512, 2) fwd(Args a) {
    extern __shared__ __attribute__((aligned(16))) unsigned char lds_raw[];
    LAS unsigned char* lds = (LAS unsigned char*)lds_raw;
    const int wv_ = __builtin_amdgcn_readfirstlane((int)threadIdx.x >> 6);
    const int tid = otid(wv_);
    const int G = gridDim.x; const int bx = blockIdx.x;
    const int vcu = (G % 8 == 0) ? (bx % 8) * (G / 8) + bx / 8 : bx;
    volatile LAS unsigned* barw = (volatile LAS unsigned*)(lds + BARW_OFF);
    if (tid < 2) barw[tid] = 0u;
    if (tid == 64) {
        LAS unsigned long long* pt = (LAS unsigned long long*)(lds + PTAB_OFF);
        pt[SLOT_x] = (unsigned long long)a.x;
        pt[SLOT_c] = (unsigned long long)a.c;
        pt[SLOT_ctx] = (unsigned long long)a.ctx;
        pt[SLOT_c_ctx] = (unsigned long long)a.c_ctx;
        pt[SLOT_w_ada] = (unsigned long long)a.w_ada;
        pt[SLOT_b_ada] = (unsigned long long)a.b_ada;
        pt[SLOT_norm1_w] = (unsigned long long)a.norm1_w;
        pt[SLOT_norm2_w] = (unsigned long long)a.norm2_w;
        pt[SLOT_w_in] = (unsigned long long)a.w_in;
        pt[SLOT_b_gates] = (unsigned long long)a.b_gates;
        pt[SLOT_q_norm_w] = (unsigned long long)a.q_norm_w;
        pt[SLOT_k_norm_w] = (unsigned long long)a.k_norm_w;
        pt[SLOT_attn_sink] = (unsigned long long)a.attn_sink;
        pt[SLOT_mlstm_norm_w] = (unsigned long long)a.mlstm_norm_w;
        pt[SLOT_w_out] = (unsigned long long)a.w_out;
        pt[SLOT_w_router] = (unsigned long long)a.w_router;
        pt[SLOT_b_router] = (unsigned long long)a.b_router;
        pt[SLOT_w_gate_up] = (unsigned long long)a.w_gate_up;
        pt[SLOT_b_gate_up] = (unsigned long long)a.b_gate_up;
        pt[SLOT_w_down] = (unsigned long long)a.w_down;
        pt[SLOT_b_down] = (unsigned long long)a.b_down;
        pt[SLOT_out] = (unsigned long long)a.out;
        pt[SLOT_ws] = (unsigned long long)a.ws;
    }
    __syncthreads();
    unsigned char* ws0 = (unsigned char*)AP(ws);
    XcdBarrier bar; bar.bar = (unsigned*)(ws0 + WS_CTL) + CW_BAR; bar.x = 0; bar.st = barw; bar.wv = wv_;
    const bool multi = (a.ph_hi - a.ph_lo) > 1;
    if (multi) bar = xcd_barrier_post((unsigned*)(ws0 + WS_CTL) + CW_BAR, barw, wv_);
    const int lo = a.ph_lo, hi = a.ph_hi;
#define PH_MASK PMASK
#define IN(k) (lo <= (k) && (k) < hi)
#define INL(j) (((PH_MASK >> ((j) + 1)) & 1) && IN(pb + (j)))
#define SEAM(k) do { if (IN(k) && IN((k) + 1)) xcd_barrier(bar); } while (0)
#define REP(t) for (int rep_ = 0; rep_ < (((DUP_MASK >> (t)) & 1u) ? 2 : 1); ++rep_, (rep_ < (((DUP_MASK >> (t)) & 1u) ? 2 : 1) && multi) ? xcd_barrier(bar) : (void)0)
    if ((PH_MASK & 1) && IN(0)) { REP(0) phase_prologue(lds, wv_, opqi(vcu), opqi(G)); }
    SEAM(0);
#pragma unroll
    for (int layer = 0; layer < DEPTH; ++layer) {
        const int pb = 1 + 8 * layer;
        const int Mrows = layer == 0 ? TT : TL;
        if (INL(0)) {
            if (layer == 0) {
                const int first = opqi(vcu) & 1;
#pragma clang loop unroll(disable)
                for (int stg = 0; stg < 2; ++stg) {
                    if ((stg ^ first) == 0) phase_norm<false, false, false>(lds, wv_, layer, opqi(vcu), opqi(G));
                    else conv_static(lds, wv_, 0, CV_NPJ, opqi(vcu), opqi(G));
                }
            } else phase_norm<false, true, true>(lds, wv_, layer, opqi(vcu), opqi(G));
        }
        SEAM(pb + 0);
        if (INL(1)) REP(2) {
            unsigned char* ws = ((unsigned char*)AP(ws));
            SrcDense8 S; S.A = (const char*)(ws + WS_HX); S.Bt = (const char*)(ws + WS_WIN) + (size_t)layer * DINM * DM; S.K = DM;
            gm::InProjOrder O; O.init(opqi(G), opqi(bx), layer == 0 ? 1 : 0);
            LAS float* ec = (LAS float*)(lds + EC_OFF);
            { const int tid = otid(wv_); __syncthreads();
              for (int i = tid; i < 2176; i += 512) ec[i] = i < 2048 ? ((const float*)(ws + WS_ROPE))[i] : (i < 2112 ? AP(q_norm_w)[layer * 64 + i - 2048] : AP(k_norm_w)[layer * 64 + i - 2112]);
              __syncthreads(); }
            EpiInProj E; E.PR = (bf16*)(ws + WS_PR); E.ec = ec;
            gm::gemm_phase(lds, wv_, S, O, E);
            conv_fill(lds, wv_, layer == 0 ? 0 : 3, opqi(bx), opqi(vcu), opqi(G));
        }
        SEAM(pb + 1);
        if (INL(2)) REP(3) {
            const int grp = opqi(vcu) & 3;
#pragma clang loop unroll(disable)
            for (int stg = 0; stg < 3; ++stg) {
                const int what = grp == 0 ? stg : (grp == 1 ? (stg == 0 ? 1 : (stg == 1 ? 0 : 2)) : (grp == 2 ? (stg == 0 ? 2 : (stg == 1 ? 0 : 1)) : 2 - stg));
                if (what == 0) conv_static(lds, wv_, CV_G0 + layer * (CV_N_GU / 2), CV_N_GU / 2, opqi(vcu), opqi(G));
                else if (what == 1) {
                    for (int it = opqi(vcu), Gm = opqi(G); it < 256; it += Gm) mlstm_item(lds, wv_, layer, it);
                } else {
                    const int nlat = NB * 16 * 4, nctx = layer == 0 ? NB * 2 * 4 : 0;
                    for (int it = opqi(vcu), Ga = opqi(G); it < nlat + nctx; it += Ga) {
                        int ab, an, ah, ag;
                        if (it < nlat) { ab = it >> 6; an = (it >> 2) & 15; ah = 0; ag = it & 3; }
                        else { const int j = it - nlat; ab = j >> 3; an = -1; ah = (j >> 2) & 1; ag = j & 3; }
                        attn_unit(lds, wv_, layer, ab, an, ah, ag);
                    }
                }
            }
            if (layer == 0) conv_fill(lds, wv_, 1, opqi(bx), opqi(vcu), opqi(G));
        }
        SEAM(pb + 2);
        if (INL(3)) { REP(4) phase_mlcomb(lds, wv_, layer, opqi(vcu), opqi(G)); }
        SEAM(pb + 3);
        if (INL(4)) REP(5) {
            unsigned char* ws = ((unsigned char*)AP(ws));
            SrcDense8 S; S.A = (const char*)(ws + WS_CAT); S.Bt = (const char*)(ws + WS_WOUT) + (size_t)layer * DM * DM; S.K = DM;
            gm::StaticOrder O; O.init(Mrows / 256, DM / 256, opqi(G), opqi(bx));
            EpiOutProj E; E.baseLat = AP(x); E.baseCtx = AP(ctx); E.baseB = layer == 0 ? (const bf16*)nullptr : (const bf16*)(ws + WS_XA);
            E.outp = (bf16*)(ws + WS_XB); E.g1 = (const float*)(ws + WS_MOD) + (size_t)layer * 9 * MODW + 2 * DM; E.wvi = wv_;
            gm::gemm_phase(lds, wv_, S, O, E);
            if (layer == 0) conv_fill(lds, wv_, 2, opqi(bx), opqi(vcu), opqi(G));
        }
        SEAM(pb + 4);
        if (INL(5)) {
            if (layer != DEPTH - 1) {
                const int first = opqi(vcu) & 1;
#pragma clang loop unroll(disable)
                for (int stg = 0; stg < 2; ++stg) {
                    if ((stg ^ first) == 0) phase_norm<true, false, true>(lds, wv_, layer, opqi(vcu), opqi(G));
                    else if (layer == 0) conv_static(lds, wv_, CV_D0, CV_N_D / 2, opqi(vcu), opqi(G));
                }
            } else {
                const int first = opqi(vcu) & 1;
#pragma clang loop unroll(disable)
                for (int stg = 0; stg < 2; ++stg) {
                    if ((stg ^ first) == 0) phase_norm<true, false, true>(lds, wv_, layer, opqi(vcu), opqi(G));
                    else conv_drain(lds, wv_, opqi(bx), opqi(vcu), opqi(G));
                }
            }
        }
        SEAM(pb + 5);
        if (INL(6)) REP(7) {
            unsigned char* ws = ((unsigned char*)AP(ws));
            const ETab T = build_etab(lds, wv_, (const unsigned*)(ws + WS_CTL) + CW_CNT + 32 * layer);
            LAS int* ec = (LAS int*)(lds + EC_OFF);
            SrcGateUp S; S.A = (const char*)(ws + WS_HX); S.Bt = (const char*)(ws + WS_WGU) + (size_t)layer * NEXP * 2048 * DM; S.ec = ec; S.T = T; S.K = DM;
            gm::StaticOrder O; O.init(T.pbase[NEXP], 8, opqi(G), opqi(bx));
            { const int* idxl = (const int*)(ws + WS_IDXL); const float* bgu = AP(b_gate_up) + (size_t)layer * NEXP * 2048;
              ec_preload(wv_, O, [&](int i, const gm::Unit& u, int tid) {
                  const int e = T.pe[u.pm], lp = u.pm - T.pbase[e], ne = T.cnt[e];
                  if (tid < 256) { const int li = lp * 256 + tid; ec[i * 512 + tid] = li < ne ? idxl[(size_t)e * TT + li] : 0; }
                  else { const int t = tid - 256; ((LAS float*)ec)[i * 512 + 256 + t] = bgu[(size_t)e * 2048 + (t >> 7) * 1024 + 128 * u.pn + (t & 127)]; } }); }
            EpiGateUp E; E.H = (bf16*)(ws + WS_H); E.ec = (const LAS float*)ec; E.T = T;
            gm::gemm_phase(lds, wv_, S, O, E);
        }
        SEAM(pb + 6);
        if (INL(7)) REP(8) {
            unsigned char* ws = ((unsigned char*)AP(ws));
            const ETab T = build_etab(lds, wv_, (const unsigned*)(ws + WS_CTL) + CW_CNT + 32 * layer);
            SrcDown S; S.A = (const char*)(ws + WS_H); S.Bt = (const char*)(ws + WS_WD) + (size_t)layer * NEXP * DM * DFF; S.T = T; S.K = DFF;
            gm::StaticOrder O; O.init(T.pbase[NEXP], 8, opqi(G), opqi(bx));
            LAS float* ec = (LAS float*)(lds + EC_OFF);
            { const float* bd = AP(b_down) + (size_t)layer * NEXP * DM; const float* WL = (const float*)(ws + WS_WL);
              ec_preload(wv_, O, [&](int i, const gm::Unit& u, int tid) {
                  const int e = T.pe[u.pm], lp = u.pm - T.pbase[e], ne = T.cnt[e];
                  if (tid < 256) ec[i * 512 + tid] = bd[(size_t)e * DM + 256 * u.pn + tid];
                  else { const int li = lp * 256 + tid - 256; ec[i * 512 + tid] = li < ne ? WL[(size_t)e * TT + li] : 0.0f; } }); }
            EpiDown E; E.Y = (bf16*)(ws + WS_Y); E.ec = ec; E.T = T;
            gm::gemm_phase(lds, wv_, S, O, E);
        }
        SEAM(pb + 7);
    }
    if (((PH_MASK >> 17) & 1) && IN(17)) { REP(17) phase_final(lds, wv_, opqi(vcu), opqi(G)); }
#undef IN
#undef INL
#undef SEAM
#undef REP
#undef PH_MASK
}

typedef void (*kern_t)(Args);
#if MK_ONE_LAUNCH
static kern_t g_kern[1] = { fwd<0x3ffffu> };
#else
static kern_t g_kern[10] = { fwd<1u << 0>, fwd<1u << 1>, fwd<1u << 2>, fwd<1u << 3>, fwd<1u << 4>, fwd<1u << 5>, fwd<1u << 6>, fwd<1u << 7>, fwd<1u << 8>, fwd<1u << 17> };
#endif
extern "C" void kernel_launch(void* const* d_in, const int* in_sizes, int n_in, void* d_out, int out_size, void* d_ws, size_t ws_size, hipStream_t stream) {
    static int grid = 0;
    constexpr int NK = (int)(sizeof(g_kern) / sizeof(g_kern[0]));
    if (grid == 0) {
        if (n_in != 21 || out_size != TL * DM || ws_size < WS_END) { fprintf(stderr, "kernel_launch: unexpected problem (n_in %d, out %d, ws %zu)\n", n_in, out_size, ws_size); grid = -1; return; }
        int dev = 0, cus = 0;
        if (hipGetDevice(&dev) != hipSuccess || hipDeviceGetAttribute(&cus, hipDeviceAttributeMultiprocessorCount, dev) != hipSuccess) { grid = -1; return; }
        for (int k = 0; k < NK; ++k)
            if (hipFuncSetAttribute((const void*)g_kern[k], hipFuncAttributeMaxDynamicSharedMemorySize, LDS_BYTES) != hipSuccess) { fprintf(stderr, "kernel_launch: hipFuncSetAttribute failed\n"); grid = -1; return; }
        int per_cu = 0;
        if (hipOccupancyMaxActiveBlocksPerMultiprocessor(&per_cu, (const void*)g_kern[0], 512, LDS_BYTES) != hipSuccess || per_cu < 1) { fprintf(stderr, "kernel_launch: occupancy query says %d\n", per_cu); }
        (void)hipGetLastError();
        grid = cus;
    }
    if (grid < 0) return;
    (void)hipMemsetAsync((char*)d_ws + WS_CTL, 0, CTL_BYTES, stream);
    Args a{};
    const float** p = (const float**)&a;
    for (int i = 0; i < 21; ++i) p[i] = (const float*)d_in[i];
    a.out = (float*)d_out; a.ws = (unsigned char*)d_ws;
#if MK_ONE_LAUNCH
    a.ph_lo = 0; a.ph_hi = NPH;
    hipLaunchKernelGGL(g_kern[0], dim3(grid), dim3(512), LDS_BYTES, stream, a);
#else
    for (int ph = 0; ph < NPH; ++ph) {
        a.ph_lo = ph; a.ph_hi = ph + 1;
        const int t = ph == 0 ? 0 : (ph == NPH - 1 ? 9 : (ph - 1) % 8 + 1);
        hipLaunchKernelGGL(g_kern[t], dim3(grid), dim3(512), LDS_BYTES, stream, a);
    }
#endif
}
```

```cpp
#include <hip/hip_runtime.h>
#include <cstdio>
#include <cstdint>

#ifndef DUP_MASK
#define DUP_MASK 0u
#endif
#ifndef DUP_ATT
#define DUP_ATT 0
#endif
#ifndef DUP_ML
#define DUP_ML 0
#endif
#ifndef MK_ONE_LAUNCH
#define MK_ONE_LAUNCH 1
#endif

#define LAS __attribute__((address_space(3)))
#define GAS __attribute__((address_space(1)))
typedef unsigned short bf16;
typedef short bf16x8 __attribute__((ext_vector_type(8)));
typedef short bf16x4 __attribute__((ext_vector_type(4)));
typedef float f32x4 __attribute__((ext_vector_type(4)));
typedef float f32x2 __attribute__((ext_vector_type(2)));
typedef unsigned u32x4 __attribute__((ext_vector_type(4)));
typedef unsigned u32x2 __attribute__((ext_vector_type(2)));
typedef int i32x4 __attribute__((ext_vector_type(4)));

constexpr int NB = 8, SEQ = 2048, DM = 2048, CTXL = 256, DEPTH = 2;
constexpr int TL = NB * SEQ, TC = NB * CTXL, TT = TL + TC;
constexpr int DIN = 4624, DINM = 4608, NEXP = 32, DFF = 1024, MODW = 6 * DM;
constexpr int MAXPANEL = 320, MAXSLOT = MAXPANEL * 256;
constexpr float EPS = 1e-6f;
constexpr float LOG2E = 1.4426950408889634f;

constexpr size_t MiB = 1u << 20;
constexpr size_t WS_CTL = 0, CTL_BYTES = 1 * MiB;
constexpr size_t WS_ROPE = 1 * MiB;
constexpr size_t WS_WGP = 2 * MiB;
constexpr size_t WS_WRP = 3 * MiB;
constexpr size_t WS_MOD = 4 * MiB;
constexpr size_t WS_GATES = 5 * MiB;
constexpr size_t WS_TOKE = 7 * MiB;
constexpr size_t WS_TOKP = 8 * MiB;
constexpr size_t WS_IDXL = 9 * MiB;
constexpr size_t WS_WL = 12 * MiB;
constexpr size_t WS_WIN = 16 * MiB;
constexpr size_t WS_WOUT = 52 * MiB;
constexpr size_t WS_WGU = 68 * MiB;
constexpr size_t WS_WD = 580 * MiB;
constexpr size_t WS_HX = 836 * MiB;
constexpr size_t WS_PR = 908 * MiB;
constexpr size_t WS_HF = 1070 * MiB;
constexpr size_t WS_HB = 1106 * MiB;
constexpr size_t WS_CAT = 1142 * MiB;
constexpr size_t WS_XB = 1214 * MiB;
constexpr size_t WS_XA = 1358 * MiB;
constexpr size_t WS_H = 1502 * MiB;
constexpr size_t WS_Y = 1662 * MiB;
constexpr size_t WS_GS = 1982 * MiB;
constexpr size_t WS_END = 1990 * MiB;
constexpr int CW_CNT = 64;
constexpr int CW_BAR = 4096;
constexpr int CW_CQ = 256;
constexpr int CW_TD = 320;

constexpr int LDS_BYTES = 163840;
constexpr int TBL_OFF = 161280;
constexpr int EC_OFF = 131072;
constexpr int EC_MAXU = 14;
constexpr int BARW_OFF = LDS_BYTES - 64;

struct Args {
    const float *x, *c, *ctx, *c_ctx, *w_ada, *b_ada, *norm1_w, *norm2_w, *w_in, *b_gates, *q_norm_w, *k_norm_w, *attn_sink, *mlstm_norm_w,
                *w_out, *w_router, *b_router, *w_gate_up, *b_gate_up, *w_down, *b_down;
    float* out; unsigned char* ws; int ph_lo, ph_hi;
};

enum { SLOT_x = 0, SLOT_c = 1, SLOT_ctx = 2, SLOT_c_ctx = 3, SLOT_w_ada = 4, SLOT_b_ada = 5, SLOT_norm1_w = 6, SLOT_norm2_w = 7, SLOT_w_in = 8, SLOT_b_gates = 9, SLOT_q_norm_w = 10, SLOT_k_norm_w = 11, SLOT_attn_sink = 12, SLOT_mlstm_norm_w = 13, SLOT_w_out = 14, SLOT_w_router = 15, SLOT_b_router = 16, SLOT_w_gate_up = 17, SLOT_b_gate_up = 18, SLOT_w_down = 19, SLOT_b_down = 20, SLOT_out = 21, SLOT_ws = 22 };
constexpr int PTAB_OFF = LDS_BYTES - 512;
template <class T> __device__ __forceinline__ T* ldp(LAS unsigned char* lds, int slot) {
    const unsigned long long v = *(const LAS unsigned long long*)(lds + PTAB_OFF + 8 * slot);
    const unsigned lo = __builtin_amdgcn_readfirstlane((unsigned)v), hi = __builtin_amdgcn_readfirstlane((unsigned)(v >> 32));
    return (T*)(GAS T*)(((unsigned long long)hi << 32) | lo);
}
#define AP(f) ldp<const float>(lds, SLOT_##f)

__device__ __forceinline__ unsigned f2bf(float f) { unsigned u = __float_as_uint(f); return (u + 0x7fffu + ((u >> 16) & 1u)) >> 16; }
__device__ __forceinline__ unsigned pk2(float lo, float hi) { return f2bf(lo) | (f2bf(hi) << 16); }
__device__ __forceinline__ float bf2f(unsigned b) { return __uint_as_float(b << 16); }
__device__ __forceinline__ float bflo(unsigned w) { return __uint_as_float(w << 16); }
__device__ __forceinline__ float bfhi(unsigned w) { return __uint_as_float(w & 0xffff0000u); }
__device__ __forceinline__ unsigned cvt_pk_bf16(float lo, float hi) { unsigned r; asm volatile("v_cvt_pk_bf16_f32 %0, %1, %2" : "=v"(r) : "v"(lo), "v"(hi)); return r; }
__device__ __forceinline__ float sigmoidf_(float z) { return __builtin_amdgcn_rcpf(1.0f + __expf(-z)); }
__device__ __forceinline__ int otid(int wv) { int l; asm volatile("v_mbcnt_lo_u32_b32 %0, -1, 0\n\tv_mbcnt_hi_u32_b32 %0, -1, %0" : "=v"(l)); return (wv << 6) | l; }
__device__ __forceinline__ float shx(float v, int m, int lane) { return __int_as_float(__builtin_amdgcn_ds_bpermute((lane ^ m) << 2, __float_as_int(v))); }
__device__ __forceinline__ float shup(float v, int off, int lane) { return __int_as_float(__builtin_amdgcn_ds_bpermute(((lane - off) & 63) << 2, __float_as_int(v))); }
__device__ __forceinline__ int opqi(int v) { asm volatile("" : "+s"(v)); return v; }
__device__ __forceinline__ unsigned char* opq(unsigned char* p) { unsigned z = 0; asm volatile("" : "+s"(z)); return p + z; }
__device__ __forceinline__ f32x4 zero4() {
    float a, b, c, d; asm volatile("v_mov_b32 %0, 0\n\tv_mov_b32 %1, 0\n\tv_mov_b32 %2, 0\n\tv_mov_b32 %3, 0" : "=v"(a), "=v"(b), "=v"(c), "=v"(d)); return (f32x4){a, b, c, d}; }
__device__ __forceinline__ unsigned pk4_fp8(float a, float b, float c, float d) { int w = __builtin_amdgcn_cvt_pk_fp8_f32(a, b, 0, false); w = __builtin_amdgcn_cvt_pk_fp8_f32(c, d, w, true); return (unsigned)w; }
__device__ __forceinline__ float clamp8(float v) { return fminf(fmaxf(v, -448.0f), 448.0f); }
__device__ __forceinline__ f32x4 up4_fp8(unsigned w) { const f32x2 a = __builtin_amdgcn_cvt_pk_f32_fp8((int)w, false), b = __builtin_amdgcn_cvt_pk_f32_fp8((int)w, true); return (f32x4){a[0], a[1], b[0], b[1]}; }
constexpr float Y8S = 16.0f, Y8I = 0.0625f;
constexpr float C8S = 16.0f, C8I = 0.0625f;
constexpr float W8S = 32.0f, W8I = 0.03125f;
#define LDS_WAIT() asm volatile("s_waitcnt lgkmcnt(0)" ::: "memory")
#define VM_WAIT() asm volatile("s_waitcnt vmcnt(0)" ::: "memory")

namespace gm {
constexpr int BM = 256, BK = 64, HALF = 128, HTB = HALF * BK * 2, STAGE_BYTES = 8 * HTB, NXCD = 8, WGM = 8;
__host__ __device__ __forceinline__ int lds_byte(int r, int c) { const int st = (r >> 4) * 2 + (c >> 5), rr = r & 15, cc = c & 31, ob = rr * 64 + cc * 2; return st * 1024 + (ob ^ (((ob >> 9) & 1) << 5)); }
__host__ __device__ __forceinline__ void stage_rc(int b, int& R, int& C) { const int st = b / 1024, sb = b % 1024, swz = sb ^ (((sb >> 9) & 1) << 5); R = (st >> 1) * 16 + swz / 64; C = (st & 1) * 32 + (swz % 64) / 2; }
__host__ __device__ __forceinline__ int perm32(int rho) { const int n = rho >> 4, i = rho & 15; return 8 * (i >> 2) + 4 * n + (i & 3); }
struct Unit { int pm, pn; };
typedef int v8i_t __attribute__((ext_vector_type(8)));
__device__ __forceinline__ v8i_t cat8i(bf16x8 a, bf16x8 b) { const u32x4 x = __builtin_bit_cast(u32x4, a), y = __builtin_bit_cast(u32x4, b); v8i_t r; r[0] = (int)x.x; r[1] = (int)x.y; r[2] = (int)x.z; r[3] = (int)x.w; r[4] = (int)y.x; r[5] = (int)y.y; r[6] = (int)y.z; r[7] = (int)y.w; return r; }
struct InProjOrder {
    int G, c, full;
    __device__ void init(int G_, int c_, int full_) { G = G_; c = c_; full = full_; }
    __device__ bool next(int i, Unit& u) const {
        const int nlat = 64 * 18, nwg = full ? 72 * 18 : nlat + 8 * 8;
        const long L = (long)i * G + c; if (L >= nwg) return false;
        int wgid = (int)L;
        if (!full && wgid >= nlat) { const int r = wgid - nlat, t = r & 7; u.pm = 64 + (r >> 3); u.pn = t < 2 ? 4 + t : 6 + t; return true; }
        const int nM = full ? 72 : 64, nN = 18, nw2 = nM * nN;
        { const int q = nw2 / NXCD, r = nw2 % NXCD, xcd = wgid % NXCD, off = wgid / NXCD; wgid = (xcd < r ? xcd * (q + 1) : r * (q + 1) + (xcd - r) * q) + off; }
        const int nig = WGM * nN, gid = wgid / nig, fm = gid * WGM, gsz = (nM - fm) < WGM ? (nM - fm) : WGM;
        u.pm = fm + ((wgid % nig) % gsz); u.pn = (wgid % nig) / gsz; return true;
    }
};
struct StaticOrder {
    int nM, nN, nwg, G, c;
    __device__ void init(int nM_, int nN_, int G_, int c_) { nM = nM_; nN = nN_; nwg = nM * nN; G = G_; c = c_; }
    __device__ bool next(int i, Unit& u) const {
        const long L = (long)i * G + c; if (L >= nwg) return false;
        int wgid = (int)L; { const int q = nwg / NXCD, r = nwg % NXCD, xcd = wgid % NXCD, off = wgid / NXCD; wgid = (xcd < r ? xcd * (q + 1) : r * (q + 1) + (xcd - r) * q) + off; }
        const int nig = WGM * nN, gid = wgid / nig, fm = gid * WGM, gsz = (nM - fm) < WGM ? (nM - fm) : WGM;
        u.pm = fm + ((wgid % nig) % gsz); u.pn = (wgid % nig) / gsz; return true;
    }
};

template <class Src, class Epi, class Sched>
__device__ __forceinline__ void gemm_phase(LAS unsigned char* lds, int wv_, const Src& G, const Sched& S, const Epi& E) {
    const int tid = otid(wv_), wid = __builtin_amdgcn_readfirstlane(tid >> 6), lane = tid & 63, wr = wid >> 2, wc = wid & 3, fr = lane & 15, fq = lane >> 4;
    constexpr bool FP8 = Src::FP8;
    const int KB = FP8 ? G.K : G.K * 2, nt = KB / 128;
    unsigned voffB[2];
#pragma unroll
    for (int i = 0; i < 2; ++i) { int R, C; stage_rc(tid * 16 + i * 8192, R, C); voffB[i] = (unsigned)(R * KB + 2 * C); }
    const size_t hstepB = (size_t)HALF * KB;
    const size_t hstepA = Src::GATHER ? 0 : hstepB;
    const unsigned ldsw = (unsigned)wid * 1024u;
    const int aoff = lds_byte(wr * 64 + fr, fq * 8), boff = lds_byte(wc * 32 + fr, fq * 8);
    constexpr int FD = 1024;
#define PG8_SA(b, h) (((b) * 2 + (h)) * HTB)
#define PG8_SB(b, h) ((4 + (b) * 2 + (h)) * HTB)
#define PG8_STAGE_B(bufoff, gbase) do { _Pragma("unroll") for (int _i = 0; _i < 2; ++_i) \
        __builtin_amdgcn_global_load_lds((const unsigned*)((const char*)(gbase) + voffB[_i]), (LAS unsigned*)(lds + (bufoff) + ldsw + _i * 8192), 16, 0, 0); } while (0)
#define PG8_STAGE_A(bufoff, h, kbyte) do { const char* _ap = Ab + (size_t)(kbyte) + (size_t)(h) * hstepA; _Pragma("unroll") for (int _i = 0; _i < 2; ++_i) \
        __builtin_amdgcn_global_load_lds((const unsigned*)(_ap + va[Src::GATHER ? (h) : 0][_i]), (LAS unsigned*)(lds + (bufoff) + ldsw + _i * 8192), 16, 0, 0); } while (0)
#define PG8_LDA(dst, b, h) do { _Pragma("unroll") for (int m = 0; m < 4; ++m) _Pragma("unroll") for (int k = 0; k < 2; ++k) dst[m][k] = *(const LAS bf16x8*)(lds + PG8_SA(b, h) + aoff + m * 2048 + k * FD); } while (0)
#define PG8_LDB(dst, b, h) do { _Pragma("unroll") for (int n = 0; n < 2; ++n) _Pragma("unroll") for (int k = 0; k < 2; ++k) dst[n][k] = *(const LAS bf16x8*)(lds + PG8_SB(b, h) + boff + n * 2048 + k * FD); } while (0)
#define PG8_MMA(ai, bj, At, Bt) do { __builtin_amdgcn_s_setprio(1); _Pragma("unroll") for (int m = 0; m < 4; ++m) _Pragma("unroll") for (int n = 0; n < 2; ++n) { \
        if constexpr (FP8) acc[ai][bj][m][n] = __builtin_amdgcn_mfma_scale_f32_16x16x128_f8f6f4(cat8i(Bt[n][0], Bt[n][1]), cat8i(At[m][0], At[m][1]), acc[ai][bj][m][n], 0, 0, 0, 0x7f7f7f7f, 0, 0x7f7f7f7f); \
        else { _Pragma("unroll") for (int k = 0; k < 2; ++k) acc[ai][bj][m][n] = __builtin_amdgcn_mfma_f32_16x16x32_bf16(Bt[n][k], At[m][k], acc[ai][bj][m][n], 0, 0, 0); } } \
        __builtin_amdgcn_s_setprio(0); } while (0)
#define PG8_WAIT_V(n) asm volatile("s_waitcnt vmcnt(" #n ")" ::: "memory")
#define PG8_WAIT_L(n) asm volatile("s_waitcnt lgkmcnt(" #n ")" ::: "memory")
#define PG8_BAR __builtin_amdgcn_s_barrier()
#define PG8_SCHED __builtin_amdgcn_sched_barrier(0)
    Unit cur, nxt; int ui = 0;
    if (!S.next(0, cur)) return;
    f32x4 acc[2][2][4][2];
    const f32x4 zq = zero4();
#pragma unroll
    for (int a = 0; a < 2; ++a)
#pragma unroll
        for (int b = 0; b < 2; ++b)
#pragma unroll
            for (int m = 0; m < 4; ++m)
#pragma unroll
                for (int n = 0; n < 2; ++n) acc[a][b][m][n] = zq;
    bf16x8 At[4][2], B0[2][2], B1[2][2];
    unsigned va[Src::GATHER ? 2 : 1][2];
    G.aoff(cur, tid, va, 0);
    const char* const Ab = G.abase();
    const char* cB = G.bptr(cur);
    const unsigned kstep = BK * 2;
    PG8_STAGE_B(PG8_SB(0, 0), cB); PG8_STAGE_B(PG8_SB(0, 1), cB + hstepB); PG8_STAGE_A(PG8_SA(0, 0), 0, 0u); PG8_STAGE_A(PG8_SA(0, 1), 1, 0u);
    if (wr == 1) PG8_BAR;
    PG8_WAIT_V(2); PG8_BAR;
    PG8_STAGE_B(PG8_SB(1, 0), cB + kstep); PG8_STAGE_A(PG8_SA(1, 0), 0, kstep); PG8_STAGE_B(PG8_SB(1, 1), cB + hstepB + kstep);
    PG8_WAIT_V(6); PG8_BAR;
    for (;;) {
        const bool has_next = S.next(ui + 1, nxt);
        const char* nB = cB;
        for (int t = 0; t < nt; t += 2) {
            const bool last = (t == nt - 2);
            const int fresh = __builtin_amdgcn_readfirstlane((t == 0 && ui > 0) ? 1 : 0);
#define PG8_WAIT_F8 asm volatile("s_cmp_lg_u32 %0, 0\n\ts_cbranch_scc1 .Lw%=\n\ts_waitcnt vmcnt(8)\n.Lw%=:" :: "s"(fresh) : "memory", "scc")
            PG8_STAGE_A(PG8_SA(1, 1), 1, (unsigned)(t + 1) * kstep); PG8_SCHED; PG8_LDB(B0, 0, 0); PG8_LDB(B1, 0, 1); PG8_SCHED; PG8_LDA(At, 0, 0);
            PG8_WAIT_F8; PG8_WAIT_L(0); PG8_BAR; PG8_MMA(0, 0, At, B0); PG8_MMA(0, 1, At, B1); PG8_BAR; PG8_SCHED;
            const char* b2; unsigned k2;
            if (last) { if (has_next) { G.aoff(nxt, tid, va, ui + 1); nB = G.bptr(nxt); } b2 = nB; k2 = 0u; }
            else { b2 = cB + (size_t)(t + 2) * kstep; k2 = (unsigned)(t + 2) * kstep; }
            PG8_STAGE_B(PG8_SB(0, 0), b2); PG8_STAGE_B(PG8_SB(0, 1), b2 + hstepB); PG8_STAGE_A(PG8_SA(0, 0), 0, k2); PG8_SCHED; PG8_LDA(At, 0, 1);
            PG8_WAIT_F8; PG8_WAIT_L(0); PG8_BAR; PG8_MMA(1, 0, At, B0); PG8_MMA(1, 1, At, B1); PG8_BAR; PG8_SCHED;
            PG8_STAGE_A(PG8_SA(0, 1), 1, k2); PG8_SCHED; PG8_LDB(B0, 1, 0); PG8_LDB(B1, 1, 1); PG8_SCHED; PG8_LDA(At, 1, 0);
            PG8_WAIT_V(8); PG8_WAIT_L(0); PG8_BAR; PG8_MMA(0, 0, At, B0); PG8_MMA(0, 1, At, B1); PG8_BAR; PG8_SCHED;
            PG8_STAGE_B(PG8_SB(1, 0), b2 + kstep); PG8_STAGE_B(PG8_SB(1, 1), b2 + hstepB + kstep); PG8_STAGE_A(PG8_SA(1, 0), 0, k2 + kstep); PG8_SCHED; PG8_LDA(At, 1, 1);
            PG8_WAIT_V(8); PG8_WAIT_L(0); PG8_BAR; PG8_MMA(1, 0, At, B0); PG8_MMA(1, 1, At, B1); PG8_BAR; PG8_SCHED;
        }
#undef PG8_WAIT_F8
        PG8_WAIT_V(0);
        if (wr == 0) PG8_BAR;
        E(acc, cur, wr, wc, fr, fq, ui);
        if (!has_next) break;
        const f32x4 zq2 = zero4();
#pragma unroll
        for (int a = 0; a < 2; ++a)
#pragma unroll
            for (int b = 0; b < 2; ++b)
#pragma unroll
                for (int m = 0; m < 4; ++m)
#pragma unroll
                    for (int n = 0; n < 2; ++n) acc[a][b][m][n] = zq2;
        cur = nxt; cB = nB; ++ui;
        if (wr == 1) PG8_BAR;
    }
    PG8_WAIT_V(0);
    PG8_BAR;
#undef PG8_SA
#undef PG8_SB
#undef PG8_STAGE_A
#undef PG8_STAGE_B
#undef PG8_LDA
#undef PG8_LDB
#undef PG8_MMA
#undef PG8_WAIT_V
#undef PG8_WAIT_L
#undef PG8_BAR
#undef PG8_SCHED
}
}

struct ETab { const LAS int* pe; const LAS int* pbase; const LAS int* cnt; };
__device__ __forceinline__ ETab build_etab(LAS unsigned char* lds, int wv_, const unsigned* gcnt) {
    LAS int* pe = (LAS int*)(lds + TBL_OFF); LAS int* pbase = pe + 384; LAS int* cnt = pbase + 40;
    const int tid = otid(wv_);
    __syncthreads();
    if (tid < 32) cnt[tid] = (int)gcnt[tid];
    __syncthreads();
    if (tid == 0) { int p = 0;
#pragma clang loop unroll(disable) vectorize(disable)
        for (int e = 0; e < NEXP; ++e) { pbase[e] = p; p += (cnt[e] + 255) >> 8; }
        pbase[NEXP] = p; }
    __syncthreads();
    if (tid < 384) { int e = 0;
#pragma clang loop unroll(disable) vectorize(disable)
        for (int j = 1; j <= NEXP; ++j) e += (pbase[j] <= tid) ? 1 : 0;
        pe[tid] = e < NEXP ? e : NEXP - 1; }
    __syncthreads();
    ETab t; t.pe = pe; t.pbase = pbase; t.cnt = cnt; return t;
}

template <class Sched, class F>
__device__ __forceinline__ void ec_preload(int wv_, const Sched& S, F&& fill) {
    const int tid = otid(wv_);
    __syncthreads();
    gm::Unit u;
    for (int i = 0; i < EC_MAXU && S.next(i, u); ++i) fill(i, u, tid);
    __syncthreads();
}
struct SrcDense {
    const char* A; const char* Bt; int K;
    __device__ __forceinline__ const char* abase() const { return A; }
    __device__ __forceinline__ const char* bptr(const gm::Unit& u) const { return Bt + (size_t)u.pn * 256 * K * 2; }
    static constexpr bool GATHER = false, FP8 = false;
    __device__ __forceinline__ void aoff(const gm::Unit& u, int tid, unsigned (&va)[1][2], int) const {
        asm volatile("" : "+v"(tid));
#pragma unroll
        for (int i = 0; i < 2; ++i) { int R, C; gm::stage_rc(tid * 16 + i * 8192, R, C); va[0][i] = (unsigned)((u.pm * 256 + R) * K + C) * 2u; }
    }
};
struct SrcDense8 {
    const char* A; const char* Bt; int K;
    __device__ __forceinline__ const char* abase() const { return A; }
    __device__ __forceinline__ const char* bptr(const gm::Unit& u) const { return Bt + (size_t)u.pn * 256 * K; }
    static constexpr bool GATHER = false, FP8 = true;
    __device__ __forceinline__ void aoff(const gm::Unit& u, int tid, unsigned (&va)[1][2], int) const {
        asm volatile("" : "+v"(tid));
#pragma unroll
        for (int i = 0; i < 2; ++i) { int R, C; gm::stage_rc(tid * 16 + i * 8192, R, C); va[0][i] = (unsigned)((u.pm * 256 + R) * K + 2 * C); }
    }
};
struct SrcGateUp {
    const char* A; const char* Bt; const LAS int* ec; ETab T; int K;
    __device__ __forceinline__ const char* abase() const { return A; }
    __device__ __forceinline__ const char* bptr(const gm::Unit& u) const { const int e = T.pe[u.pm]; return Bt + ((size_t)e * 2048 + (size_t)u.pn * 256) * 2048; }
    static constexpr bool GATHER = true, FP8 = true;
    __device__ __forceinline__ void aoff(const gm::Unit& u, int tid, unsigned (&va)[2][2], int ui) const {
        asm volatile("" : "+v"(tid));
        const LAS int* ix = ec + (ui < EC_MAXU ? ui : EC_MAXU - 1) * 512;
#pragma unroll
        for (int i = 0; i < 2; ++i) { int R, C; gm::stage_rc(tid * 16 + i * 8192, R, C);
#pragma unroll
            for (int h = 0; h < 2; ++h) va[h][i] = (unsigned)(ix[h * 128 + R] * 2048 + 2 * C); }
    }
};
struct SrcDown {
    const char* A; const char* Bt; ETab T; int K;
    __device__ __forceinline__ const char* abase() const { return A; }
    __device__ __forceinline__ const char* bptr(const gm::Unit& u) const { const int e = T.pe[u.pm]; return Bt + ((size_t)e * 2048 + (size_t)u.pn * 256) * 1024; }
    static constexpr bool GATHER = false, FP8 = true;
    __device__ __forceinline__ void aoff(const gm::Unit& u, int tid, unsigned (&va)[1][2], int) const {
        asm volatile("" : "+v"(tid));
#pragma unroll
        for (int i = 0; i < 2; ++i) { int R, C; gm::stage_rc(tid * 16 + i * 8192, R, C); va[0][i] = (unsigned)((u.pm * 256 + R) * K + 2 * C); }
    }
};

#define EPI_BEGIN(ai, m) do { f32x4 _a0 = acc[ai][0][m][0], _a1 = acc[ai][0][m][1], _a2 = acc[ai][1][m][0], _a3 = acc[ai][1][m][1]; asm volatile("" : "+v"(_a0), "+v"(_a1), "+v"(_a2), "+v"(_a3)); A00 = _a0; A01 = _a1; A10 = _a2; A11 = _a3; } while (0)
#define EPI_END(x) asm volatile("" :: "v"(x) : "memory")
struct EpiInProj {
    bf16* PR; const LAS float* ec;
    __device__ __forceinline__ void operator()(const f32x4 (&acc)[2][2][4][2], const gm::Unit& u, int wr, int wc, int fr, int fq, int ui) const {
        const int pn = u.pn, lane = fq * 16 + fr;
        char* const ubase = (char*)PR + ((size_t)u.pm * 256 * DINM + 256 * pn) * 2;
        unsigned lo_qk = (unsigned)(((wr * 64 + fr) * DINM + 64 * wc + 16 * fq) * 2), lo_pl = (unsigned)(((wr * 64 + fr) * DINM + 32 * wc + 8 * fq) * 2);
        unsigned zz = 0, ro = (unsigned)((fr * 16 + 4 * fq) * 8), rq = (unsigned)(4 * fq * 8), nwo = (unsigned)(4 * fq * 4); asm volatile("" : "+v"(lo_qk), "+v"(lo_pl), "+v"(ro), "+v"(rq), "+v"(nwo), "+s"(zz));
        if (pn < 5) {
            const LAS char* nw = (const LAS char*)(ec + (pn < 4 ? 2048 : 2112));
            const float qs = pn < 4 ? 0.125f * LOG2E : 1.0f;
            const bool lat = u.pm < 64;
            f32x4 w[2][2];
#pragma unroll
            for (int bj = 0; bj < 2; ++bj)
#pragma unroll
                for (int n = 0; n < 2; ++n) w[bj][n] = *(const LAS f32x4*)(nw + nwo + (32 * bj + 16 * n) * 4);
#pragma unroll
            for (int ai = 0; ai < 2; ++ai) {
                f32x4 tr0, tr1, tc0[4], tc1[4];
                {
                    const int prow = (4 * u.pm + 2 * ai + wr) & 31;
                    const LAS float* rp = (const LAS float*)((const LAS char*)ec + prow * 128 + rq);
                    tr0 = *(const LAS f32x4*)rp; tr1 = *(const LAS f32x4*)(rp + 4);
                }
#pragma unroll
                for (int m = 0; m < 4; ++m) {
                    if ((m & 1) == 0) {
#pragma unroll
                        for (int mm = m; mm < m + 2; ++mm) { const LAS float* cp = (const LAS float*)((const LAS char*)ec + ro + mm * 2048); tc0[mm] = *(const LAS f32x4*)cp; tc1[mm] = *(const LAS f32x4*)(cp + 4); }
                    }
                    f32x4 y[2][2];
                    float ss = 0.f;
#pragma unroll
                    for (int bj = 0; bj < 2; ++bj)
#pragma unroll
                        for (int n = 0; n < 2; ++n) { const f32x4 v = acc[ai][bj][m][n] * W8I; y[bj][n] = v; ss += (v[0] * v[0] + v[1] * v[1]) + (v[2] * v[2] + v[3] * v[3]); }
                    ss += shx(ss, 16, lane); ss += shx(ss, 32, lane);
                    const float rstd = rsqrtf(ss * (1.0f / 64.0f) + EPS) * qs;
#pragma unroll
                    for (int bj = 0; bj < 2; ++bj)
#pragma unroll
                        for (int n = 0; n < 2; ++n) y[bj][n] = y[bj][n] * rstd * w[bj][n];
                    if (lat) {
#pragma unroll
                        for (int bj = 0; bj < 2; ++bj) {
                            const f32x4 t0 = bj ? tc0[m] : tr0, t1 = bj ? tc1[m] : tr1;
                            const f32x4 cs = (f32x4){t0[0], t0[2], t1[0], t1[2]}, sn = (f32x4){t0[1], t0[3], t1[1], t1[3]};
                            const f32x4 o0 = y[bj][0] * cs - y[bj][1] * sn, o1 = y[bj][1] * cs + y[bj][0] * sn;
                            y[bj][0] = o0; y[bj][1] = o1;
                        }
                    }
                    char* dst = ubase + (lo_qk + (unsigned)((ai * 128 + m * 16) * DINM * 2));
#pragma unroll
                    for (int bj = 0; bj < 2; ++bj) {
                        u32x4 pk; pk.x = cvt_pk_bf16(y[bj][0][0], y[bj][0][1]); pk.y = cvt_pk_bf16(y[bj][0][2], y[bj][0][3]); pk.z = cvt_pk_bf16(y[bj][1][0], y[bj][1][1]); pk.w = cvt_pk_bf16(y[bj][1][2], y[bj][1][3]);
                        *(u32x4*)(dst + 16 * bj) = pk;
                    }
                }
            }
        } else {
            const float sc = ((pn == 8 || pn == 9) ? 0.08838834764831845f : 1.0f) * W8I;
#pragma unroll
            for (int ai = 0; ai < 2; ++ai)
#pragma unroll
                for (int m = 0; m < 4; ++m) {
                    char* rowp = ubase + (lo_pl + (unsigned)((ai * 128 + m * 16) * DINM * 2));
#pragma unroll
                    for (int bj = 0; bj < 2; ++bj) {
                        const f32x4 v0 = acc[ai][bj][m][0] * sc, v1 = acc[ai][bj][m][1] * sc;
                        u32x4 pk; pk.x = cvt_pk_bf16(v0[0], v0[1]); pk.y = cvt_pk_bf16(v0[2], v0[3]); pk.z = cvt_pk_bf16(v1[0], v1[1]); pk.w = cvt_pk_bf16(v1[2], v1[3]);
                        *(u32x4*)(rowp + 256 * bj) = pk;
                    }
                }
        }
    }
};
struct EpiOutProj {
    const float* baseLat; const float* baseCtx; const bf16* baseB; bf16* outp; const float* g1; int wvi;
    __device__ __forceinline__ void operator()(const f32x4 (&acc)[2][2][4][2], const gm::Unit& u, int wr, int wc, int fr, int fq, int ui) const {
        const int pm = u.pm;
        const int mb = pm < 64 ? (pm >> 3) : 8;
        { const int l2 = otid(wvi) & 63; fr = l2 & 15; fq = l2 >> 4; }
        const int col0 = 256 * u.pn + 32 * wc + 8 * fq;
        char* const obase = (char*)outp + (size_t)pm * 256 * DM * 2;
        unsigned lo0 = (unsigned)((wr * 64 + fr) * DM + col0); unsigned zz = 0; asm volatile("" : "+v"(lo0), "+s"(zz));
        const float* gp = g1 + (size_t)mb * MODW + col0 + zz;
        f32x4 gv[2][2];
#pragma unroll
        for (int bj = 0; bj < 2; ++bj)
#pragma unroll
            for (int n = 0; n < 2; ++n) gv[bj][n] = *(const f32x4*)(gp + 128 * bj + 4 * n) * (W8I * C8I);
#pragma unroll
        for (int ai = 0; ai < 2; ++ai) {
            f32x4 bs[4][2][2];
            if (baseB) {
                const char* bb = (const char*)baseB + (size_t)pm * 256 * DM * 2;
#pragma unroll
                for (int m = 0; m < 4; ++m)
#pragma unroll
                    for (int bj = 0; bj < 2; ++bj) { const u32x4 w = *(const u32x4*)(bb + ((lo0 + (unsigned)((ai * 128 + m * 16) * DM) + 128 * bj) * 2));
                        bs[m][bj][0] = (f32x4){bflo(w.x), bfhi(w.x), bflo(w.y), bfhi(w.y)}; bs[m][bj][1] = (f32x4){bflo(w.z), bfhi(w.z), bflo(w.w), bfhi(w.w)}; }
            } else {
                const char* bf = (const char*)(pm < 64 ? baseLat + (size_t)pm * 256 * DM : baseCtx + (size_t)(pm - 64) * 256 * DM);
#pragma unroll
                for (int m = 0; m < 4; ++m)
#pragma unroll
                    for (int bj = 0; bj < 2; ++bj)
#pragma unroll
                        for (int n = 0; n < 2; ++n) bs[m][bj][n] = *(const f32x4*)(bf + ((lo0 + (unsigned)((ai * 128 + m * 16) * DM) + 128 * bj + 4 * n) * 4));
            }
#pragma unroll
            for (int m = 0; m < 4; ++m)
#pragma unroll
                for (int bj = 0; bj < 2; ++bj) {
                    const f32x4 o0 = bs[m][bj][0] + gv[bj][0] * acc[ai][bj][m][0], o1 = bs[m][bj][1] + gv[bj][1] * acc[ai][bj][m][1];
                    u32x4 pk; pk.x = cvt_pk_bf16(o0[0], o0[1]); pk.y = cvt_pk_bf16(o0[2], o0[3]); pk.z = cvt_pk_bf16(o1[0], o1[1]); pk.w = cvt_pk_bf16(o1[2], o1[3]);
                    *(u32x4*)(obase + ((lo0 + (unsigned)((ai * 128 + m * 16) * DM) + 128 * bj) * 2)) = pk;
                }
        }
    }
};
struct EpiGateUp {
    bf16* H; const LAS float* ec; ETab T;
    __device__ __forceinline__ void operator()(const f32x4 (&acc)[2][2][4][2], const gm::Unit& u, int wr, int wc, int fr, int fq, int ui) const {
        const int e = T.pe[u.pm], j0 = 128 * u.pn + 32 * wc + 8 * fq;
        char* const hbase = (char*)H + (size_t)u.pm * 256 * DFF;
        unsigned lo0 = (unsigned)((wr * 64 + fr) * DFF + j0); unsigned zz = 0; asm volatile("" : "+v"(lo0), "+s"(zz));
        const LAS float* bgp = ec + (ui < EC_MAXU ? ui : EC_MAXU - 1) * 512 + 256 + 32 * wc + 8 * fq;
        f32x4 bg[2], bu[2];
#pragma unroll
        for (int n = 0; n < 2; ++n) { bg[n] = *(const LAS f32x4*)(bgp + 4 * n); bu[n] = *(const LAS f32x4*)(bgp + 128 + 4 * n); }
#pragma unroll
        for (int ai = 0; ai < 2; ++ai)
#pragma unroll
            for (int m = 0; m < 4; ++m) {
                float hv[8];
#pragma unroll
                for (int n = 0; n < 2; ++n)
#pragma unroll
                    for (int i = 0; i < 4; ++i) {
                        const float gt = fminf(acc[ai][0][m][n][i] * W8I + bg[n][i], 7.0f);
                        const float up = fminf(fmaxf(acc[ai][1][m][n][i] * W8I + bu[n][i], -7.0f), 7.0f);
                        hv[4 * n + i] = (up + 1.0f) * gt * sigmoidf_(1.702f * gt);
                    }
                u32x2 pk; pk.x = pk4_fp8(hv[0], hv[1], hv[2], hv[3]); pk.y = pk4_fp8(hv[4], hv[5], hv[6], hv[7]);
                *(u32x2*)(hbase + (lo0 + (unsigned)((ai * 128 + m * 16) * DFF))) = pk;
            }
    }
};
struct EpiDown {
    bf16* Y; const LAS float* ec; ETab T;
    __device__ __forceinline__ void operator()(const f32x4 (&acc)[2][2][4][2], const gm::Unit& u, int wr, int wc, int fr, int fq, int ui) const {
        const int e = T.pe[u.pm], lp = u.pm - T.pbase[e], ne = T.cnt[e];
        const int col0 = 256 * u.pn + 64 * wc + 16 * fq;
        char* const ybase = (char*)Y + (size_t)u.pm * 256 * DM;
        unsigned lo0 = (unsigned)((wr * 64 + fr) * DM + col0); unsigned zz = 0; asm volatile("" : "+v"(lo0), "+s"(zz));
        const LAS float* ecu = ec + (ui < EC_MAXU ? ui : EC_MAXU - 1) * 512;
        f32x4 bv[2][2]; float wt[2][4];
#pragma unroll
        for (int bj = 0; bj < 2; ++bj)
#pragma unroll
            for (int n = 0; n < 2; ++n) bv[bj][n] = *(const LAS f32x4*)(ecu + 64 * wc + 16 * fq + 8 * bj + 4 * n);
#pragma unroll
        for (int ai = 0; ai < 2; ++ai)
#pragma unroll
            for (int m = 0; m < 4; ++m) wt[ai][m] = ecu[256 + ai * 128 + wr * 64 + m * 16 + fr];
#pragma unroll
        for (int ai = 0; ai < 2; ++ai)
#pragma unroll
            for (int m = 0; m < 4; ++m) {
                char* rowp = ybase + (lo0 + (unsigned)((ai * 128 + m * 16) * DM));
                const float ws_ = wt[ai][m] * Y8S;
                u32x4 pk;
                { const f32x4 v0 = (acc[ai][0][m][0] * W8I + bv[0][0]) * ws_, v1 = (acc[ai][0][m][1] * W8I + bv[0][1]) * ws_; pk.x = pk4_fp8(v0[0], v0[1], v0[2], v0[3]); pk.y = pk4_fp8(v1[0], v1[1], v1[2], v1[3]); }
                { const f32x4 v0 = (acc[ai][1][m][0] * W8I + bv[1][0]) * ws_, v1 = (acc[ai][1][m][1] * W8I + bv[1][1]) * ws_; pk.z = pk4_fp8(v0[0], v0[1], v0[2], v0[3]); pk.w = pk4_fp8(v1[0], v1[1], v1[2], v1[3]); }
                *(u32x4*)rowp = pk;
            }
    }
};

#define XB_TMO      128
#define XB_XCNT(j)  (256  + 64 * (j))
#define XB_XSUB(j)  (1280 + 64 * (j))
#define XB_XGEN(j)  (2304 + 64 * (j))
#define XB_TOP      3328
#define XB_TOPGEN   3392
#define XCD_BAR_WORDS 3456
#define XB_SPIN_CAP (1u << 24)
__device__ __forceinline__ unsigned xb_ld(unsigned* p)              { return __hip_atomic_load(p, __ATOMIC_RELAXED, __HIP_MEMORY_SCOPE_AGENT); }
__device__ __forceinline__ unsigned xb_add(unsigned* p, unsigned v) { return __hip_atomic_fetch_add(p, v, __ATOMIC_RELAXED, __HIP_MEMORY_SCOPE_AGENT); }
__device__ __forceinline__ unsigned xb_xcc_id() { return (unsigned)__builtin_amdgcn_s_getreg((3 << 11) | 20) & 0xFu; }
#define XB_SPIN(cond, bar) do { unsigned _sp = 0; while (cond) { __builtin_amdgcn_s_sleep(1); \
    if ((++_sp & 255u) == 0u) { if (xb_ld(&(bar)[XB_TMO])) break; if (_sp > XB_SPIN_CAP) { atomicAdd(&(bar)[XB_TMO], 1u); break; } } } } while (0)
struct XcdBarrier { unsigned* bar; unsigned x; volatile LAS unsigned* st; int wv; };
__device__ __forceinline__ XcdBarrier xcd_barrier_post(unsigned* bar, volatile LAS unsigned* st, int wv_) {
    XcdBarrier b; b.bar = bar; b.x = xb_xcc_id(); b.st = st; b.wv = wv_;
    if (otid(wv_) == 0) (void)xb_add(&bar[XB_XCNT(b.x)], 1u);
    return b;
}
__device__ __forceinline__ void xcd_barrier_complete(unsigned* bar, unsigned x, unsigned& nloc, unsigned& nx) {
    const unsigned G = gridDim.x * gridDim.y * gridDim.z;
    unsigned sum, cnt, mine, sp = 0u;
    for (;;) {
        sum = 0u; cnt = 0u; mine = 0u;
#pragma clang loop unroll(disable) vectorize(disable)
        for (unsigned j = 0; j < 16; ++j) { const unsigned c = xb_ld(&bar[XB_XCNT(j)]); sum += c; cnt += (c > 0u) ? 1u : 0u; mine = (j == x) ? c : mine; }
        if (sum == G) break;
        __builtin_amdgcn_s_sleep(1);
        if ((++sp & 255u) == 0u) { if (xb_ld(&bar[XB_TMO])) break; if (sp > XB_SPIN_CAP) { atomicAdd(&bar[XB_TMO], 1u); break; } }
    }
    nloc = mine > 0u ? mine : 1u; nx = cnt > 0u ? cnt : 1u;
}
__device__ __forceinline__ void xcd_barrier(const XcdBarrier& b) {
    const int wv_ = b.wv;
    asm volatile("s_waitcnt vmcnt(0)" ::: "memory");
    __syncthreads();
    if (otid(wv_) == 0) {
        unsigned* bar = b.bar; asm volatile("" : "+s"(bar));
        __builtin_amdgcn_s_waitcnt(0);
        unsigned nloc = b.st[0], nx = b.st[1];
        if (nloc == 0u) { xcd_barrier_complete(bar, b.x, nloc, nx); b.st[0] = nloc; b.st[1] = nx; }
        const unsigned old = xb_add(&bar[XB_XSUB(b.x)], 1u);
        const unsigned gen = old / nloc;
        if (old + 1u == (gen + 1u) * nloc) {
            __builtin_amdgcn_fence(__ATOMIC_RELEASE, "agent");
            asm volatile("s_waitcnt vmcnt(0)" ::: "memory");
            const unsigned og = xb_add(&bar[XB_TOP], 1u);
            const unsigned tg = og / nx;
            if (og + 1u == (tg + 1u) * nx) xb_add(&bar[XB_TOPGEN], 1u);
            else XB_SPIN(xb_ld(&bar[XB_TOPGEN]) == tg, bar);
            __builtin_amdgcn_fence(__ATOMIC_ACQUIRE, "agent");
            xb_add(&bar[XB_XGEN(b.x)], 1u);
            asm volatile("s_waitcnt vmcnt(0)" ::: "memory");
        } else {
            XB_SPIN(xb_ld(&bar[XB_XGEN(b.x)]) == gen, bar);
            __builtin_amdgcn_fence(__ATOMIC_ACQUIRE, "agent");
            asm volatile("s_waitcnt vmcnt(0)" ::: "memory");
        }
    }
    __syncthreads();
}

__device__ __forceinline__ void conv_item(const float* W, int ldw, int K, int k0, int src0, bf16* WT, size_t dstrow0, bool perm, LAS float* scr, int lane) {
    f32x4 v[8];
#pragma unroll
    for (int i = 0; i < 8; ++i) v[i] = *(const f32x4*)(W + (size_t)(k0 + (lane >> 3) + 8 * i) * ldw + src0 + 4 * (lane & 7));
#pragma unroll
    for (int i = 0; i < 8; ++i) { LAS float* s = scr + ((lane >> 3) + 8 * i) * 33 + 4 * (lane & 7); s[0] = v[i][0]; s[1] = v[i][1]; s[2] = v[i][2]; s[3] = v[i][3]; }
    LDS_WAIT(); asm volatile("" ::: "memory");
    const int c = lane & 7;
#pragma unroll
    for (int jj = 0; jj < 4; ++jj) {
        const int j = (lane >> 3) + 8 * jj, sc = perm ? gm::perm32(j) : j;
        const LAS float* s = scr + (8 * c) * 33 + sc;
        u32x4 o; o.x = pk2(s[0 * 33], s[1 * 33]); o.y = pk2(s[2 * 33], s[3 * 33]); o.z = pk2(s[4 * 33], s[5 * 33]); o.w = pk2(s[6 * 33], s[7 * 33]);
        *(u32x4*)(WT + (dstrow0 + j) * (size_t)K + k0 + 8 * c) = o;
    }
    LDS_WAIT(); asm volatile("" ::: "memory");
}

__device__ __forceinline__ void conv_item8(const float* W, int ldw, int K, int k0, int src0, unsigned char* WT8, size_t dstrow0, bool perm, LAS float* scr, int lane) {
    f32x4 v[8];
#pragma unroll
    for (int i = 0; i < 8; ++i) v[i] = *(const f32x4*)(W + (size_t)(k0 + (lane >> 3) + 8 * i) * ldw + src0 + 4 * (lane & 7));
#pragma unroll
    for (int i = 0; i < 8; ++i) { LAS float* s = scr + ((lane >> 3) + 8 * i) * 33 + 4 * (lane & 7); s[0] = v[i][0]; s[1] = v[i][1]; s[2] = v[i][2]; s[3] = v[i][3]; }
    LDS_WAIT(); asm volatile("" ::: "memory");
    const int j = lane >> 1, hf = lane & 1, sc = perm ? gm::perm32(j) : j;
    const LAS float* s = scr + (32 * hf) * 33 + sc;
    u32x4 o0, o1;
    o0.x = pk4_fp8(s[0 * 33] * W8S, s[1 * 33] * W8S, s[2 * 33] * W8S, s[3 * 33] * W8S);     o0.y = pk4_fp8(s[4 * 33] * W8S, s[5 * 33] * W8S, s[6 * 33] * W8S, s[7 * 33] * W8S);
    o0.z = pk4_fp8(s[8 * 33] * W8S, s[9 * 33] * W8S, s[10 * 33] * W8S, s[11 * 33] * W8S);   o0.w = pk4_fp8(s[12 * 33] * W8S, s[13 * 33] * W8S, s[14 * 33] * W8S, s[15 * 33] * W8S);
    o1.x = pk4_fp8(s[16 * 33] * W8S, s[17 * 33] * W8S, s[18 * 33] * W8S, s[19 * 33] * W8S); o1.y = pk4_fp8(s[20 * 33] * W8S, s[21 * 33] * W8S, s[22 * 33] * W8S, s[23 * 33] * W8S);
    o1.z = pk4_fp8(s[24 * 33] * W8S, s[25 * 33] * W8S, s[26 * 33] * W8S, s[27 * 33] * W8S); o1.w = pk4_fp8(s[28 * 33] * W8S, s[29 * 33] * W8S, s[30 * 33] * W8S, s[31 * 33] * W8S);
    unsigned char* d = WT8 + (dstrow0 + j) * (size_t)K + k0 + 32 * hf;
    *(u32x4*)d = o0; *(u32x4*)(d + 16) = o1;
    LDS_WAIT(); asm volatile("" ::: "memory");
}

struct CvItem { const float* src; unsigned char* dst; int ldw, K, k0; size_t dstrow0; bool perm, f8, p64; };
constexpr int CV_I_IN = 16 * 144, CV_I_OUT = 16 * 64, CV_I_GU = 16 * 64, CV_I_D = 8 * 64;
constexpr int CV_N_IN = DEPTH * CV_I_IN, CV_N_OUT = DEPTH * CV_I_OUT, CV_N_GU = DEPTH * NEXP * CV_I_GU, CV_N_D = DEPTH * NEXP * CV_I_D, CV_N_ALL = CV_N_IN + CV_N_OUT + CV_N_GU + CV_N_D;
constexpr int CV_NQ = CV_N_D / 2;
constexpr int CV_NPJ = CV_N_IN + CV_N_OUT;
constexpr int CV_NP = 0;
__device__ __forceinline__ int cv_pmap(int p) { return p; }
constexpr int CV_D0 = CV_N_IN + CV_N_OUT + CV_N_GU;
constexpr int CV_G0 = CV_N_IN + CV_N_OUT;
__device__ __forceinline__ int cv_qmap(int q) { return CV_N_IN + CV_N_OUT + CV_N_GU + CV_N_D / 2 + q; }
__device__ __forceinline__ CvItem cv_decode(LAS unsigned char* lds, int it) {
    unsigned char* ws = ((unsigned char*)AP(ws));
    CvItem d; d.p64 = false; int r = it;
    if (r < CV_N_IN) {
        const int l = r / CV_I_IN; r %= CV_I_IN; const int kb = r / 144, g = r % 144, pn = g >> 3, c0 = (g & 7) * 32;
        int src0; if (pn < 5) { const int bj = c0 >> 7, wc = (c0 >> 5) & 3; src0 = 256 * pn + 64 * wc + 32 * bj; d.perm = false; } else { src0 = 256 * pn + c0; d.perm = true; }
        d.src = AP(w_in) + (size_t)l * DM * DIN + src0; d.ldw = DIN; d.K = DM; d.k0 = kb * 128; d.dst = (unsigned char*)(ws + WS_WIN) + (size_t)l * DINM * DM; d.dstrow0 = (size_t)g * 32; d.f8 = true; return d;
    }
    r -= CV_N_IN;
    if (r < CV_N_OUT) {
        const int l = r / CV_I_OUT; r %= CV_I_OUT; const int kb = r / 64, g = r % 64;
        d.src = AP(w_out) + (size_t)l * DM * DM + g * 32; d.ldw = DM; d.K = DM; d.k0 = kb * 128; d.dst = (unsigned char*)(ws + WS_WOUT) + (size_t)l * DM * DM; d.dstrow0 = (size_t)g * 32; d.perm = true; d.f8 = true; return d;
    }
    r -= CV_N_OUT;
    if (r < CV_N_GU) {
        const int le = r / CV_I_GU; r %= CV_I_GU; const int kb = (r & 7) + 8 * (r >> 9), g = (r >> 3) & 63, pn = g >> 3,        c0 = (g & 7) * 32, bj = c0 >> 7, gg = (c0 >> 5) & 3;
        d.src = AP(w_gate_up) + (size_t)le * DM * 2048 + bj * 1024 + 128 * pn + 32 * gg; d.ldw = 2048; d.K = DM; d.k0 = kb * 128; d.dst = (unsigned char*)(ws + WS_WGU) + (size_t)le * 2048 * DM; d.dstrow0 = (size_t)g * 32; d.perm = true; d.f8 = true; return d;
    }
    r -= CV_N_GU;
    const int le = r / CV_I_D; r %= CV_I_D; const int kb = r & 7, g = r >> 3;
    d.src = AP(w_down) + (size_t)le * DFF * DM + (g >> 3) * 256 + 64 * (g & 3) + 8 * ((g >> 2) & 1); d.ldw = DM; d.K = DFF; d.k0 = kb * 128; d.dst = (unsigned char*)(ws + WS_WD) + (size_t)le * DM * DFF; d.dstrow0 = (size_t)g * 32; d.perm = true; d.f8 = true; d.p64 = true; return d;
}
__device__ __forceinline__ void cv_issue(const CvItem& d, f32x4 (&v)[16], int lane) {
    const int co = d.p64 ? 16 * ((lane & 7) >> 1) + 4 * (lane & 1) : 4 * (lane & 7);
#pragma unroll
    for (int i = 0; i < 16; ++i) if (i < 8 || d.f8) v[i] = __builtin_nontemporal_load((const f32x4*)(d.src + (size_t)(d.k0 + (lane >> 3) + 8 * i) * d.ldw + co));
}
__device__ __forceinline__ void cv_to_lds(const CvItem& d, const f32x4 (&v)[16], LAS float* scr, int lane) {
#pragma unroll
    for (int i = 0; i < 16; ++i) if (i < 8 || d.f8) { LAS float* sp = scr + ((lane >> 3) + 8 * i) * 33 + 4 * (lane & 7); sp[0] = v[i][0]; sp[1] = v[i][1]; sp[2] = v[i][2]; sp[3] = v[i][3]; }
    LDS_WAIT(); asm volatile("" ::: "memory");
}
__device__ __forceinline__ void cv_finish(const CvItem& d, LAS float* scr, int lane) {
    if (d.f8) {
        const int j = lane & 31, hf = lane >> 5, scn = d.perm ? gm::perm32(j) : j;
        const LAS float* sp = scr + (64 * hf) * 33 + scn;
        unsigned char* dp = d.dst + (d.dstrow0 + j) * (size_t)d.K + d.k0 + 64 * hf;
#pragma unroll
        for (int q = 0; q < 4; ++q) {
            u32x4 o;
            o.x = pk4_fp8(sp[(16 * q + 0) * 33] * W8S, sp[(16 * q + 1) * 33] * W8S, sp[(16 * q + 2) * 33] * W8S, sp[(16 * q + 3) * 33] * W8S);
            o.y = pk4_fp8(sp[(16 * q + 4) * 33] * W8S, sp[(16 * q + 5) * 33] * W8S, sp[(16 * q + 6) * 33] * W8S, sp[(16 * q + 7) * 33] * W8S);
            o.z = pk4_fp8(sp[(16 * q + 8) * 33] * W8S, sp[(16 * q + 9) * 33] * W8S, sp[(16 * q + 10) * 33] * W8S, sp[(16 * q + 11) * 33] * W8S);
            o.w = pk4_fp8(sp[(16 * q + 12) * 33] * W8S, sp[(16 * q + 13) * 33] * W8S, sp[(16 * q + 14) * 33] * W8S, sp[(16 * q + 15) * 33] * W8S);
            *(u32x4*)(dp + 16 * q) = o;
        }
    } else {
        const int c = lane & 7;
#pragma unroll
        for (int jj = 0; jj < 4; ++jj) {
            const int j = (lane >> 3) + 8 * jj, scn = d.perm ? gm::perm32(j) : j;
            const LAS float* sp = scr + (8 * c) * 33 + scn;
            u32x4 o; o.x = pk2(sp[0 * 33], sp[1 * 33]); o.y = pk2(sp[2 * 33], sp[3 * 33]); o.z = pk2(sp[4 * 33], sp[5 * 33]); o.w = pk2(sp[6 * 33], sp[7 * 33]);
            *(u32x4*)(d.dst + ((d.dstrow0 + j) * (size_t)d.K + d.k0 + 8 * c) * 2) = o;
        }
    }
    LDS_WAIT(); asm volatile("" ::: "memory");
}
#ifndef FS_CAP0
#define FS_CAP0 24
#define FS_CAP1 20
#define FS_CAP2 22
#define FS_CAP3 24
#endif
constexpr int CV_FW = 1;
constexpr int CW_PROG = 65536;
__device__ __forceinline__ int fs_rem(int s, int G) { const int n = s == 0 ? 72 * 18 : (s == 3 ? 64 * 18 + 64 : 576); return n % G; }
__device__ __forceinline__ int fs_cap(int s) { return s == 0 ? FS_CAP0 : s == 1 ? FS_CAP1 : s == 2 ? FS_CAP2 : FS_CAP3; }
__device__ __forceinline__ void fs_params(int s, int bx, int vcu, int G, int& rank, int& nidle, int& qb) {
    qb = 0;
    for (int j = 0; j < s; ++j) { const int r = fs_rem(j, G); qb += (r ? G - r : 0) * CV_FW * fs_cap(j); }
    const int r = fs_rem(s, G); nidle = r ? G - r : 0; rank = r ? (s == 1 ? vcu : bx) - r : -1;
}
__device__ __forceinline__ int fs_total(int G) { int q = 0; for (int j = 0; j < 4; ++j) { const int r = fs_rem(j, G); q += (r ? G - r : 0) * CV_FW * fs_cap(j); } return (G <= 256 && q <= CV_NQ) ? q : -1; }
__device__ __forceinline__ void conv_fill(LAS unsigned char* lds, int wv_, int s, int bx, int vcu, int G) {
    const int tid = otid(wv_), lane = tid & 63, wave = __builtin_amdgcn_readfirstlane(tid >> 6);
    unsigned* ctl = (unsigned*)(((unsigned char*)AP(ws)) + WS_CTL);
    unsigned* dn = ctl + CW_TD + 16 * s;
    __syncthreads();
    if (tid == 0) __hip_atomic_fetch_add(dn, 1u, __ATOMIC_RELAXED, __HIP_MEMORY_SCOPE_AGENT);
    int rank, nidle, qb; fs_params(s, bx, vcu, G, rank, nidle, qb);
    if (rank >= 0 && wave < CV_FW && fs_total(G) >= 0) {
        const int K = fs_cap(s), stride = nidle * CV_FW, q0 = qb + rank * CV_FW + wave;
        LAS float* scr = (LAS float*)(lds + wave * 17408);
        f32x4 va[16];
        int k = 0;
        unsigned dv = __hip_atomic_load(dn, __ATOMIC_RELAXED, __HIP_MEMORY_SCOPE_AGENT);
        if ((int)__builtin_amdgcn_readfirstlane(dv) < G) {
            CvItem da = cv_decode(lds, cv_qmap(q0)); cv_issue(da, va, lane);
#pragma clang loop unroll(disable)
            for (;;) {
                const CvItem d = da;
                cv_to_lds(d, va, scr, lane);
                dv = __hip_atomic_load(dn, __ATOMIC_RELAXED, __HIP_MEMORY_SCOPE_AGENT);
                const bool more = k + 1 < K;
                if (more) { da = cv_decode(lds, cv_qmap(q0 + (k + 1) * stride)); cv_issue(da, va, lane); }
                cv_finish(d, scr, lane);
                ++k;
                if (!more || (int)__builtin_amdgcn_readfirstlane(dv) >= G) break;
            }
        }
        if (lane == 0) __hip_atomic_store(ctl + CW_PROG + (s * 256 + bx) * 8 + wave, (unsigned)k, __ATOMIC_RELAXED, __HIP_MEMORY_SCOPE_AGENT);
    }
    __syncthreads();
}
__device__ __forceinline__ void conv_drain(LAS unsigned char* lds, int wv_, int bx, int vcu, int G) {
    const int tid = otid(wv_), lane = tid & 63, wave = __builtin_amdgcn_readfirstlane(tid >> 6);
    unsigned* ctl = (unsigned*)(((unsigned char*)AP(ws)) + WS_CTL);
    __syncthreads();
    LAS float* scr = (LAS float*)(lds + wave * 17408);
    f32x4 va[16];
    const int qt = fs_total(G);
    if (qt >= 0) {
        int pos = 0;
#pragma clang loop unroll(disable)
        for (int s = 0; s < 4; ++s) {
            int rank, nidle, qb; fs_params(s, bx, vcu, G, rank, nidle, qb);
            if (rank < 0) continue;
            const int K = fs_cap(s), stride = nidle * CV_FW;
#pragma clang loop unroll(disable)
            for (int w = 0; w < CV_FW; ++w) {
                const int k0 = (int)__builtin_amdgcn_readfirstlane(__hip_atomic_load(ctl + CW_PROG + (s * 256 + bx) * 8 + w, __ATOMIC_RELAXED, __HIP_MEMORY_SCOPE_AGENT));
#pragma clang loop unroll(disable)
                for (int k = k0; k < K; ++k, ++pos) {
                    if ((pos & 7) != wave) continue;
                    const CvItem d = cv_decode(lds, cv_qmap(qb + k * stride + rank * CV_FW + w));
                    cv_issue(d, va, lane); cv_to_lds(d, va, scr, lane); cv_finish(d, scr, lane);
                }
            }
        }
    }
    {
        const int NGW = G * 8, first = (qt >= 0 ? qt : 0) + vcu * 8 + wave;
        CvItem da = cv_decode(lds, cv_qmap(first < CV_NQ ? first : 0));
        if (first < CV_NQ) cv_issue(da, va, lane);
#pragma clang loop unroll(disable)
        for (int it = first; it < CV_NQ; it += NGW) {
            const CvItem d = da;
            cv_to_lds(d, va, scr, lane);
            if (it + NGW < CV_NQ) { da = cv_decode(lds, cv_qmap(it + NGW)); cv_issue(da, va, lane); }
            cv_finish(d, scr, lane);
        }
    }
    __syncthreads();
}

__device__ __forceinline__ void conv_static(LAS unsigned char* lds, int wv_, int base, int count, int vcu, int G) {
    const int tid = otid(wv_), lane = tid & 63, wave = __builtin_amdgcn_readfirstlane(tid >> 6);
    __syncthreads();
    LAS float* scr = (LAS float*)(lds + wave * 17408);
    f32x4 va[16], vb[16];
    const int NGW = G * 8, first = vcu * 8 + wave;
    CvItem da = cv_decode(lds, base + (first < count ? first : 0)), db = cv_decode(lds, base + (first + NGW < count ? first + NGW : 0));
    if (first < count) cv_issue(da, va, lane);
    if (first + NGW < count) cv_issue(db, vb, lane);
#pragma clang loop unroll(disable)
    for (int it = first; it < count; it += 2 * NGW) {
        {
            const CvItem d = da;
            cv_to_lds(d, va, scr, lane);
            if (it + 2 * NGW < count) { da = cv_decode(lds, base + it + 2 * NGW); cv_issue(da, va, lane); }
            cv_finish(d, scr, lane);
        }
        if (it + NGW < count) {
            const CvItem d = db;
            cv_to_lds(d, vb, scr, lane);
            if (it + 3 * NGW < count) { db = cv_decode(lds, base + it + 3 * NGW); cv_issue(db, vb, lane); }
            cv_finish(d, scr, lane);
        }
    }
    __syncthreads();
}

__device__ __forceinline__ void phase_prologue(LAS unsigned char* lds, int wv_, int vcu, int G) {
    const int tid = otid(wv_), lane = tid & 63, wave = __builtin_amdgcn_readfirstlane(tid >> 6);
    unsigned char* ws = ((unsigned char*)AP(ws));
    {
        const int gt = vcu * 512 + tid, NG = G * 512;
        float* rope = (float*)(ws + WS_ROPE);
        for (int it = gt; it < 64 * 16; it += NG) {
            const int pos = it >> 4, f = it & 15;
            double th = 1.0; for (int j = 0; j < f; ++j) th *= 0.5623413251903491;
            double s1 = 0.0, c1 = 0.0, term = 1.0;
            for (int n = 0; n < 24; ++n) { if ((n & 1) == 0) c1 += ((n >> 1) & 1) ? -term : term; else s1 += ((n >> 1) & 1) ? -term : term; term *= th / (double)(n + 1); }
            double cr = 1.0, sr = 0.0;
            for (int j = 0; j < pos; ++j) { const double nc = cr * c1 - sr * s1, ns = sr * c1 + cr * s1; cr = nc; sr = ns; }
            rope[it * 2] = (float)cr; rope[it * 2 + 1] = (float)sr;
        }
        float* wgp = (float*)(ws + WS_WGP);
        for (int it = gt; it < DEPTH * DM * 16; it += NG) {
            const int l = it / (DM * 16), r = it % (DM * 16), k = r >> 4, j = r & 15;
            const int s = k >> 5, g = (k >> 3) & 3, i = k & 7;
            wgp[(size_t)l * DM * 16 + ((s * 4 + g) * 16 + j) * 8 + i] = AP(w_in)[((size_t)l * DM + k) * DIN + DINM + j];
        }
        float* wrp = (float*)(ws + WS_WRP);
        for (int it = gt; it < DEPTH * DM * 32; it += NG) {
            const int l = it / (DM * 32), r = it % (DM * 32), k = r >> 5, jj = r & 31, tile = jj >> 4, j = jj & 15;
            const int s = k >> 5, g = (k >> 3) & 3, i = k & 7;
            wrp[(size_t)l * DM * 32 + (((s * 4 + g) * 2 + tile) * 16 + j) * 8 + i] = AP(w_router)[((size_t)l * DM + k) * NEXP + jj];
        }
    }
    {
        __syncthreads();
        LAS float* sc = (LAS float*)lds;
        LAS float* red = (LAS float*)(lds + 73728);
        bool staged = false;
        for (int it = vcu; it < 256; it += G) {
            if (!staged) {
                for (int i = tid; i < 9 * DM; i += 512) { const int r = i / DM, k = i % DM; const float v = r < 8 ? AP(c)[r * DM + k] : AP(c_ctx)[k]; sc[i] = v / (1.0f + __expf(-v)); }
                staged = true;
            }
            __syncthreads();
            const int l = it >> 7, cg = it & 127, lc = lane < 48 ? lane : 47, col = cg * 96 + 2 * lc;
            const float* W = AP(w_ada) + (size_t)l * DM * MODW + col;
            float acc[9][2];
#pragma unroll
            for (int r = 0; r < 9; ++r) { acc[r][0] = 0.f; acc[r][1] = 0.f; }
            for (int k16 = 0; k16 < 16; ++k16) {
                const int k = wave * 256 + k16 * 16;
                f32x2 w[16];
#pragma unroll
                for (int j = 0; j < 16; ++j) w[j] = *(const f32x2*)(W + (size_t)(k + j) * MODW);
#pragma unroll
                for (int r = 0; r < 9; ++r) {
#pragma unroll
                    for (int q = 0; q < 4; ++q) {
                        const f32x4 sv = *(const LAS f32x4*)(sc + r * DM + k + 4 * q);
#pragma unroll
                        for (int j = 0; j < 4; ++j) { acc[r][0] += sv[j] * w[4 * q + j][0]; acc[r][1] += sv[j] * w[4 * q + j][1]; }
                    }
                }
            }
            if (lane < 48) {
#pragma unroll
                for (int r = 0; r < 9; ++r) { red[(wave * 9 + r) * 96 + 2 * lane] = acc[r][0]; red[(wave * 9 + r) * 96 + 2 * lane + 1] = acc[r][1]; }
            }
            __syncthreads();
            for (int i = tid; i < 9 * 96; i += 512) {
                const int r = i / 96, cc = i % 96; float sum = 0.f;
#pragma unroll
                for (int w = 0; w < 8; ++w) sum += red[(w * 9 + r) * 96 + cc];
                ((float*)(ws + WS_MOD))[((size_t)l * 9 + r) * MODW + cg * 96 + cc] = sum + AP(b_ada)[(size_t)l * MODW + cg * 96 + cc];
            }
        }
        __syncthreads();
    }
    {
        LAS float* scr = (LAS float*)(lds + wave * 17408);
        const int gw = vcu * 8 + wave, NGW = G * 8;
        f32x4 va[16];
        CvItem da = cv_decode(lds, cv_pmap(gw < CV_NP ? gw : 0));
        if (gw < CV_NP) cv_issue(da, va, lane);
        for (int it = gw; it < CV_NP; it += NGW) {
            const CvItem d = da;
            cv_to_lds(d, va, scr, lane);
            if (it + NGW < CV_NP) { da = cv_decode(lds, cv_pmap(it + NGW)); cv_issue(da, va, lane); }
            cv_finish(d, scr, lane);
        }
    }
}

template <bool ROUTER, bool COMBINE, bool XBF  >
__device__ __forceinline__ void phase_norm(LAS unsigned char* lds, int wv_, int layer, int vcu, int G) {
    const int tid = otid(wv_), lane = tid & 63, wave = __builtin_amdgcn_readfirstlane(tid >> 6), r = lane & 15, g = lane >> 4;
    unsigned char* ws = ((unsigned char*)AP(ws));
    const float* MOD = (const float*)(ws + WS_MOD) + (size_t)layer * 9 * MODW;
    const float* nw = (ROUTER ? AP(norm2_w) : AP(norm1_w)) + (size_t)layer * DM;
    const int off_sh = ROUTER ? 3 * DM : 0, off_sc = ROUTER ? 4 * DM : DM;
    const int nrows = ROUTER ? (layer == 0 ? TT : TL) : TT;
    const int ngroups = nrows / 16;
    constexpr bool combine = COMBINE;
    LAS float* part0 = (LAS float*)(lds);
    LAS float* red0 = (LAS float*)(lds + 1024);
    LAS float* logit0 = (LAS float*)(lds + 1024 + 32768);
    LAS float* topv0 = logit0 + 1024;
    LAS int* topi0 = (LAS int*)(topv0 + 128);
    LAS int* ent_tok = (LAS int*)(lds + 49152);
    LAS int* ent_e = ent_tok + 1024; LAS int* ent_lp = ent_e + 1024; LAS float* ent_w = (LAS float*)(ent_lp + 1024);
    LAS int* lcount = (LAS int*)(ent_w + 1024); LAS int* lbase = lcount + 32; LAS int* nent = lbase + 32;
    ETab T; T.pe = nullptr; T.pbase = nullptr; T.cnt = nullptr;
    if (combine) T = build_etab(lds, wv_, (const unsigned*)(ws + WS_CTL) + CW_CNT);
    if (ROUTER) { if (tid < 32) lcount[tid] = 0; if (tid == 0) nent[0] = 0; }
    __syncthreads();
    const float* wpk = ROUTER ? (const float*)(ws + WS_WRP) + (size_t)layer * DM * 32 : (const float*)(ws + WS_WGP) + (size_t)layer * DM * 16;
    constexpr int NT = ROUTER ? 2 : 1;
    const int kb = wave * 256 + 8 * g;
    const float* xlat = AP(x); const float* xctx = AP(ctx);
    const bf16* xbb = (const bf16*)(ws + WS_XB);
    f32x4 xn[8][2]; u32x4 xr[8]; i32x4 ten = (i32x4){0, 0, 0, 0}, tpn = (i32x4){0, 0, 0, 0};
#define NORM_ISSUE(rg_) do { const int row_ = (rg_) * 16 + r; \
        if (XBF) { const bf16* sb_ = xbb + (size_t)row_ * DM + kb; _Pragma("unroll") for (int s = 0; s < 8; ++s) xr[s] = *(const u32x4*)(sb_ + 32 * s); } \
        else { const float* src_ = (row_ < TL ? xlat + (size_t)row_ * DM : xctx + (size_t)(row_ - TL) * DM) + kb; \
            _Pragma("unroll") for (int s = 0; s < 8; ++s) { xn[s][0] = *(const f32x4*)(src_ + 32 * s); xn[s][1] = *(const f32x4*)(src_ + 32 * s + 4); } } \
        if (combine) { ten = *(const i32x4*)((const int*)(ws + WS_TOKE) + (size_t)row_ * 4); tpn = *(const i32x4*)((const int*)(ws + WS_TOKP) + (size_t)row_ * 4); } } while (0)
    if (!COMBINE && vcu < ngroups) NORM_ISSUE(vcu);
    int par = 0;
    for (int rg = vcu; rg < ngroups; rg += G, par ^= 1) {
        LAS float* part = part0 + par * 128; LAS float* red = red0 + par * 4096; LAS float* logit = logit0 + par * 512;
        const int row = rg * 16 + r;
        const int mb = row < TL ? (row >> 11) : 8;
        if (COMBINE) NORM_ISSUE(rg);
        f32x4 xv[8][2];
#pragma unroll
        for (int s = 0; s < 8; ++s) {
            if (XBF) { xv[s][0] = (f32x4){bflo(xr[s].x), bfhi(xr[s].x), bflo(xr[s].y), bfhi(xr[s].y)}; xv[s][1] = (f32x4){bflo(xr[s].z), bfhi(xr[s].z), bflo(xr[s].w), bfhi(xr[s].w)}; }
            else { xv[s][0] = xn[s][0]; xv[s][1] = xn[s][1]; } }
        const i32x4 te = ten, tp = tpn;
        if (!COMBINE && rg + G < ngroups) NORM_ISSUE(rg + G);
        if (combine) {
            const float* g2 = (const float*)(ws + WS_MOD) + (size_t)mb * MODW + 5 * DM + kb;
            const unsigned char* Y = (const unsigned char*)(ws + WS_Y);
            bf16* xa = (bf16*)(ws + WS_XA) + (size_t)row * DM + kb;
            const unsigned char* y0 = Y + ((size_t)T.pbase[te[0]] * 256 + tp[0]) * DM + kb; const unsigned char* y1 = Y + ((size_t)T.pbase[te[1]] * 256 + tp[1]) * DM + kb;
            const unsigned char* y2 = Y + ((size_t)T.pbase[te[2]] * 256 + tp[2]) * DM + kb; const unsigned char* y3 = Y + ((size_t)T.pbase[te[3]] * 256 + tp[3]) * DM + kb;
            u32x2 ya[8], yb[8], yc[8], yd[8];
#pragma unroll
            for (int s = 0; s < 8; ++s) ya[s] = *(const u32x2*)(y0 + 32 * s);
#pragma unroll
            for (int s = 0; s < 8; ++s) yb[s] = *(const u32x2*)(y1 + 32 * s);
#pragma unroll
            for (int s = 0; s < 8; ++s) yc[s] = *(const u32x2*)(y2 + 32 * s);
#pragma unroll
            for (int s = 0; s < 8; ++s) yd[s] = *(const u32x2*)(y3 + 32 * s);
#pragma unroll
            for (int s = 0; s < 8; ++s) {
                const f32x4 s0 = ((up4_fp8(ya[s].x) + up4_fp8(yb[s].x)) + (up4_fp8(yc[s].x) + up4_fp8(yd[s].x))) * Y8I;
                const f32x4 s1 = ((up4_fp8(ya[s].y) + up4_fp8(yb[s].y)) + (up4_fp8(yc[s].y) + up4_fp8(yd[s].y))) * Y8I;
                xv[s][0] = xv[s][0] + *(const f32x4*)(g2 + 32 * s) * s0;
                xv[s][1] = xv[s][1] + *(const f32x4*)(g2 + 32 * s + 4) * s1;
                { u32x4 pk; pk.x = cvt_pk_bf16(xv[s][0][0], xv[s][0][1]); pk.y = cvt_pk_bf16(xv[s][0][2], xv[s][0][3]); pk.z = cvt_pk_bf16(xv[s][1][0], xv[s][1][1]); pk.w = cvt_pk_bf16(xv[s][1][2], xv[s][1][3]); *(u32x4*)(xa + 32 * s) = pk; }
            }
        }
        float ss = 0.f;
#pragma unroll
        for (int s = 0; s < 8; ++s)
#pragma unroll
            for (int h = 0; h < 2; ++h) ss += (xv[s][h][0] * xv[s][h][0] + xv[s][h][1] * xv[s][h][1]) + (xv[s][h][2] * xv[s][h][2] + xv[s][h][3] * xv[s][h][3]);
        ss += shx(ss, 16, lane); ss += shx(ss, 32, lane);
        if (g == 0) part[wave * 16 + r] = ss;
        __syncthreads();
        float tot = 0.f;
#pragma unroll
        for (int w = 0; w < 8; ++w) tot += part[w * 16 + r];
        const float rstd = rsqrtf(tot * (1.0f / DM) + EPS);
        const float* msh = MOD + (size_t)mb * MODW + off_sh + kb; const float* msc = MOD + (size_t)mb * MODW + off_sc + kb; const float* nwp = nw + kb;
#pragma unroll
        for (int s = 0; s < 8; ++s) {
#pragma unroll
            for (int h = 0; h < 2; ++h) {
                const f32x4 wv = *(const f32x4*)(nwp + 32 * s + 4 * h), scv = *(const f32x4*)(msc + 32 * s + 4 * h), shv = *(const f32x4*)(msh + 32 * s + 4 * h);
                xv[s][h] = xv[s][h] * rstd * wv * (scv + 1.0f) + shv;
            }
            { u32x2 pk; pk.x = pk4_fp8(xv[s][0][0], xv[s][0][1], xv[s][0][2], xv[s][0][3]); pk.y = pk4_fp8(xv[s][1][0], xv[s][1][1], xv[s][1][2], xv[s][1][3]);
                *(u32x2*)((unsigned char*)(ws + WS_HX) + (size_t)row * DM + kb + 32 * s) = pk; }
            if ((s & 1) == 1) asm volatile("" ::: "memory");
        }
        bf16x8 xh[8], xl[8];
#pragma unroll
        for (int s = 0; s < 8; ++s) {
            u32x4 hw, lw;
            hw.x = cvt_pk_bf16(xv[s][0][0], xv[s][0][1]); hw.y = cvt_pk_bf16(xv[s][0][2], xv[s][0][3]); hw.z = cvt_pk_bf16(xv[s][1][0], xv[s][1][1]); hw.w = cvt_pk_bf16(xv[s][1][2], xv[s][1][3]);
            lw.x = cvt_pk_bf16(xv[s][0][0] - bflo(hw.x), xv[s][0][1] - bfhi(hw.x)); lw.y = cvt_pk_bf16(xv[s][0][2] - bflo(hw.y), xv[s][0][3] - bfhi(hw.y));
            lw.z = cvt_pk_bf16(xv[s][1][0] - bflo(hw.z), xv[s][1][1] - bfhi(hw.z)); lw.w = cvt_pk_bf16(xv[s][1][2] - bflo(hw.w), xv[s][1][3] - bfhi(hw.w));
            xh[s] = __builtin_bit_cast(bf16x8, hw); xl[s] = __builtin_bit_cast(bf16x8, lw);
        }
        f32x4 acc[NT];
#pragma unroll
        for (int t = 0; t < NT; ++t) acc[t] = (f32x4){0.f, 0.f, 0.f, 0.f};
        {
            f32x4 bw[2][4][2];
#define NORM_BLOAD(buf_, b_) do { _Pragma("unroll") for (int s = 0; s < 4; ++s) { const float* bp = wpk + ((((size_t)(wave * 8 + 4 * ((b_) & 1) + s) * 4 + g) * NT + ((b_) >> 1)) * 16 + r) * 8; \
                bw[buf_][s][0] = *(const f32x4*)bp; bw[buf_][s][1] = *(const f32x4*)(bp + 4); } } while (0)
            NORM_BLOAD(0, 0);
#pragma unroll
            for (int bb = 0; bb < 2 * NT; ++bb) {
                const int t = bb >> 1, sh = bb & 1, cu = bb & 1;
                if (bb + 1 < 2 * NT) NORM_BLOAD(cu ^ 1, bb + 1);
#pragma unroll
                for (int s = 0; s < 4; ++s) {
                    u32x4 hw, lw;
                    hw.x = cvt_pk_bf16(bw[cu][s][0][0], bw[cu][s][0][1]); hw.y = cvt_pk_bf16(bw[cu][s][0][2], bw[cu][s][0][3]); hw.z = cvt_pk_bf16(bw[cu][s][1][0], bw[cu][s][1][1]); hw.w = cvt_pk_bf16(bw[cu][s][1][2], bw[cu][s][1][3]);
                    lw.x = cvt_pk_bf16(bw[cu][s][0][0] - bflo(hw.x), bw[cu][s][0][1] - bfhi(hw.x)); lw.y = cvt_pk_bf16(bw[cu][s][0][2] - bflo(hw.y), bw[cu][s][0][3] - bfhi(hw.y));
                    lw.z = cvt_pk_bf16(bw[cu][s][1][0] - bflo(hw.z), bw[cu][s][1][1] - bfhi(hw.z)); lw.w = cvt_pk_bf16(bw[cu][s][1][2] - bflo(hw.w), bw[cu][s][1][3] - bfhi(hw.w));
                    const bf16x8 wh = __builtin_bit_cast(bf16x8, hw), wl = __builtin_bit_cast(bf16x8, lw);
                    acc[t] = __builtin_amdgcn_mfma_f32_16x16x32_bf16(xl[4 * sh + s], wh, acc[t], 0, 0, 0);
                    acc[t] = __builtin_amdgcn_mfma_f32_16x16x32_bf16(xh[4 * sh + s], wl, acc[t], 0, 0, 0);
                    acc[t] = __builtin_amdgcn_mfma_f32_16x16x32_bf16(xh[4 * sh + s], wh, acc[t], 0, 0, 0);
                }
                asm volatile("" ::: "memory");
            }
#undef NORM_BLOAD
        }
#pragma unroll
        for (int t = 0; t < NT; ++t)
#pragma unroll
            for (int q = 0; q < 4; ++q) red[wave * 512 + (4 * g + q) * 32 + 16 * t + r] = acc[t][q];
        __syncthreads();
        if (!ROUTER) {
            if (tid < 256) {
                const int rr = tid >> 4, j = tid & 15; float v = 0.f;
#pragma unroll
                for (int w = 0; w < 8; ++w) v += red[w * 512 + rr * 32 + j];
                v += AP(b_gates)[layer * 16 + j];
                const float z = v * (1.0f / 15.0f);
                v = 15.0f * (1.0f - 2.0f / (__expf(2.0f * z) + 1.0f));
                ((float*)(ws + WS_GATES))[(size_t)(rg * 16 + rr) * 16 + j] = v;
            }
        } else {
            LAS float* topv = topv0 + par * 64; LAS int* topi = topi0 + par * 64;
            const int rr = tid >> 5, j = tid & 31; float v = 0.f;
#pragma unroll
            for (int w = 0; w < 8; ++w) v += red[w * 512 + rr * 32 + j];
            v += AP(b_router)[layer * NEXP + j];
            logit[rr * 32 + j] = v;
            __syncthreads();
            int rank = 0;
#pragma unroll 8
            for (int e = 0; e < NEXP; ++e) { const float o = logit[rr * 32 + e]; rank += (o > v || (o == v && e < j)) ? 1 : 0; }
            if (rank < 4) { topv[rr * 4 + rank] = v; topi[rr * 4 + rank] = j; }
            __syncthreads();
            if (tid < 64) {
                const int row2 = tid >> 2, k = tid & 3, tok = rg * 16 + row2;
                const float v0 = topv[row2 * 4 + 0], e1 = __expf(topv[row2 * 4 + 1] - v0), e2 = __expf(topv[row2 * 4 + 2] - v0), e3 = __expf(topv[row2 * 4 + 3] - v0);
                const float mine = __expf(topv[row2 * 4 + k] - v0), inv = 1.0f / (1.0f + e1 + e2 + e3);
                const int e = topi[row2 * 4 + k];
                const int base = atomicAdd((int*)nent, 1);
                const int lp = atomicAdd((int*)&lcount[e], 1);
                ent_tok[base] = tok * 4 + k; ent_e[base] = e; ent_lp[base] = lp; ent_w[base] = mine * inv;
            }
        }
    }
#undef NORM_ISSUE
    if (ROUTER) {
        __syncthreads();
        unsigned* gcnt = (unsigned*)(ws + WS_CTL) + CW_CNT + 32 * layer;
        if (tid < 32) lbase[tid] = (int)atomicAdd(&gcnt[tid], (unsigned)lcount[tid]);
        __syncthreads();
        const int n = nent[0];
        for (int i = tid; i < n; i += 512) {
            const int e = ent_e[i], pos = lbase[e] + ent_lp[i], tk = ent_tok[i];
            ((int*)(ws + WS_IDXL))[(size_t)e * TT + pos] = tk >> 2;
            ((float*)(ws + WS_WL))[(size_t)e * TT + pos] = ent_w[i];
            ((int*)(ws + WS_TOKE))[tk] = e; ((int*)(ws + WS_TOKP))[tk] = pos;
        }
    }
    __syncthreads();
}

typedef short v4i16_t __attribute__((ext_vector_type(4)));
__device__ __forceinline__ u32x2 trr(const LAS bf16* p) { return __builtin_bit_cast(u32x2, __builtin_amdgcn_ds_read_tr16_b64_v4i16((LAS v4i16_t*)p)); }
__device__ __forceinline__ bf16x8 cat8(u32x2 lo, u32x2 hi) { u32x4 w; w.x = lo.x; w.y = lo.y; w.z = hi.x; w.w = hi.y; return __builtin_bit_cast(bf16x8, w); }

__device__ __forceinline__ void attn_unit(LAS unsigned char* lds, int wv_, int layer, int b, int nblk, int half, int kvh) {
    const int tid = otid(wv_), lane = tid & 63, wave = __builtin_amdgcn_readfirstlane(tid >> 6), qi = lane & 15, gq = lane >> 4;
    unsigned char* ws = ((unsigned char*)AP(ws));
    const bf16* PR = (const bf16*)(ws + WS_PR);
    unsigned char* CAT = (unsigned char*)(ws + WS_CAT);
    LAS bf16* Lq = (LAS bf16*)(lds + 40960);
    const bool isctx = nblk < 0;
    const int qrow0 = isctx ? TL + b * CTXL + half * 128 : b * SEQ + nblk * 128;
    const int hq = kvh * 4 + (wave >> 1), qoff = (wave & 1) * 64;
    const int nloc = isctx ? 0 : 3 - (nblk == 0 ? 1 : 0) - (nblk == SEQ / 128 - 1 ? 1 : 0), j0 = (!isctx && nblk == 0) ? 1 : 0, ntile = nloc + 2;
#define T_ROW(ti_) ((ti_) < nloc ? b * SEQ + (nblk - 1 + j0 + (ti_)) * 128 : TL + b * CTXL + ((ti_) - nloc) * 128)
#define T_TL(ti_) ((ti_) < nloc ? j0 + (ti_) : 1)
    u32x4 rk[2], rv[2];
#define AT_LOAD(krow0_) do { _Pragma("unroll") for (int j = 0; j < 2; ++j) { const int cid = tid + 512 * j, key = cid >> 3, c = cid & 7; \
        rk[j] = *(const u32x4*)(PR + (size_t)((krow0_) + key) * DINM + 1024 + kvh * 64 + 8 * c); rv[j] = *(const u32x4*)(PR + (size_t)((krow0_) + key) * DINM + 1280 + kvh * 64 + 8 * c); } } while (0)
    AT_LOAD(T_ROW(0));
    __syncthreads();
#pragma unroll
    for (int j = 0; j < 8; ++j) {
        const int cid = tid + 512 * j, rowi = cid >> 3, c = cid & 7, hh = rowi >> 7, qr = rowi & 127;
        *(LAS u32x4*)(Lq + rowi * 72 + 8 * c) = *(const u32x4*)(PR + (size_t)(qrow0 + qr) * DINM + (kvh * 4 + hh) * 64 + 8 * c);
    }
    const float sinkv = AP(attn_sink)[layer * 16 + hq] * LOG2E;
    float mrun[4], lsum[4]; f32x4 o[4][4]; const f32x4 zq = zero4();
#pragma unroll
    for (int qt = 0; qt < 4; ++qt) { mrun[qt] = sinkv; lsum[qt] = 1.0f;
#pragma unroll
        for (int dt = 0; dt < 4; ++dt) o[qt][dt] = zq; }
#define AT_STAGE(set_) do { LAS bf16* Kw_ = (LAS bf16*)(lds + ((set_) ? 114688 : 0)); LAS bf16* Vw_ = Kw_ + 10240; \
        _Pragma("unroll") for (int j = 0; j < 2; ++j) { const int cid = tid + 512 * j, key = cid >> 3, c = cid & 7; *(LAS u32x4*)(Kw_ + key * 80 + 8 * c) = rk[j]; *(LAS u32x4*)(Vw_ + key * 80 + 8 * c) = rv[j]; } } while (0)
    AT_STAGE(0);
    if (ntile > 1) AT_LOAD(T_ROW(1));
    LDS_WAIT();
    __syncthreads();
#pragma unroll 1
    for (int ti = 0; ti < ntile; ++ti) {
        const int tl = T_TL(ti), cur = ti & 1;
        const LAS bf16* Kt = (const LAS bf16*)(lds + (cur ? 114688 : 0)); const LAS bf16* Vt = Kt + 10240;
        if (ti + 1 < ntile) { AT_STAGE(cur ^ 1); if (ti + 2 < ntile) AT_LOAD(T_ROW(ti + 2)); }
#pragma unroll
        for (int qp = 0; qp < 2; ++qp) {
            bf16x8 qb[2][2];
#pragma unroll
            for (int u = 0; u < 2; ++u)
#pragma unroll
                for (int kk = 0; kk < 2; ++kk) qb[u][kk] = *(const LAS bf16x8*)(Lq + ((wave >> 1) * 128 + qoff + 16 * (2 * qp + u) + qi) * 72 + 32 * kk + 8 * gq);
            f32x4 s[2][8];
            __builtin_amdgcn_s_setprio(1);
#pragma unroll
            for (int kt = 0; kt < 8; ++kt) {
                const bf16x8 ka0 = *(const LAS bf16x8*)(Kt + (16 * kt + qi) * 80 + 8 * gq), ka1 = *(const LAS bf16x8*)(Kt + (16 * kt + qi) * 80 + 32 + 8 * gq);
#pragma unroll
                for (int u = 0; u < 2; ++u) {
                    s[u][kt] = __builtin_amdgcn_mfma_f32_16x16x32_bf16(ka0, qb[u][0], (f32x4){0.f, 0.f, 0.f, 0.f}, 0, 0, 0);
                    s[u][kt] = __builtin_amdgcn_mfma_f32_16x16x32_bf16(ka1, qb[u][1], s[u][kt], 0, 0, 0);
                }
            }
            __builtin_amdgcn_s_setprio(0);
            if (tl != 1) {
                const int sgn = (tl == 0) ? 1 : -1;
#pragma unroll
                for (int u = 0; u < 2; ++u) {
                    const int dbase = 4 * gq - (qoff + 16 * (2 * qp + u) + qi);
#pragma unroll
                    for (int kt = 0; kt < 8; ++kt)
#pragma unroll
                        for (int rr = 0; rr < 4; ++rr) { const int d = sgn * (dbase + 16 * kt + rr); s[u][kt][rr] += __int_as_float((d >> 31) & (int)0xF149F2CAu); }
                }
            }
            float alpha[2];
#pragma unroll
            for (int u = 0; u < 2; ++u) {
                const int qt = 2 * qp + u;
                float mx = -1.0e30f;
#pragma unroll
                for (int kt = 0; kt < 8; ++kt) mx = fmaxf(fmaxf(mx, fmaxf(s[u][kt][0], s[u][kt][1])), fmaxf(s[u][kt][2], s[u][kt][3]));
                mx = fmaxf(mx, shx(mx, 16, lane)); mx = fmaxf(mx, shx(mx, 32, lane));
                const float mnew = fmaxf(mrun[qt], mx);
                alpha[u] = __builtin_amdgcn_exp2f(mrun[qt] - mnew);
                float rs = 0.f;
#pragma unroll
                for (int kt = 0; kt < 8; ++kt)
#pragma unroll
                    for (int rr = 0; rr < 4; ++rr) { const float p = __builtin_amdgcn_exp2f(s[u][kt][rr] - mnew); s[u][kt][rr] = p; rs += p; }
                rs += shx(rs, 16, lane); rs += shx(rs, 32, lane);
                lsum[qt] = lsum[qt] * alpha[u] + rs; mrun[qt] = mnew;
#pragma unroll
                for (int dt = 0; dt < 4; ++dt) o[qt][dt] = o[qt][dt] * alpha[u];
            }
            __builtin_amdgcn_s_setprio(1);
#pragma unroll
            for (int k2 = 0; k2 < 4; ++k2) {
                bf16x8 pb[2];
#pragma unroll
                for (int u = 0; u < 2; ++u) {
                    u32x4 pw; pw.x = cvt_pk_bf16(s[u][2 * k2][0], s[u][2 * k2][1]); pw.y = cvt_pk_bf16(s[u][2 * k2][2], s[u][2 * k2][3]); pw.z = cvt_pk_bf16(s[u][2 * k2 + 1][0], s[u][2 * k2 + 1][1]); pw.w = cvt_pk_bf16(s[u][2 * k2 + 1][2], s[u][2 * k2 + 1][3]);
                    pb[u] = __builtin_bit_cast(bf16x8, pw);
                }
#pragma unroll
                for (int dt = 0; dt < 4; ++dt) {
                    const LAS bf16* vp = Vt + (32 * k2 + 4 * gq + (qi >> 2)) * 80 + 16 * dt + 4 * (qi & 3);
                    const bf16x8 vf = cat8(trr(vp), trr(vp + 16 * 80));
                    o[2 * qp][dt] = __builtin_amdgcn_mfma_f32_16x16x32_bf16(vf, pb[0], o[2 * qp][dt], 0, 0, 0);
                    o[2 * qp + 1][dt] = __builtin_amdgcn_mfma_f32_16x16x32_bf16(vf, pb[1], o[2 * qp + 1][dt], 0, 0, 0);
                }
            }
            __builtin_amdgcn_s_setprio(0);
        }
        if (ti + 1 < ntile) { LDS_WAIT(); __syncthreads(); }
    }
#undef AT_STAGE
#undef AT_LOAD
#undef T_ROW
#undef T_TL
#pragma unroll
    for (int qt = 0; qt < 4; ++qt) {
        const float inv = 1.0f / lsum[qt];
        LAS unsigned char* st = (LAS unsigned char*)(Lq + ((wave >> 1) * 128 + qoff + 16 * qt + qi) * 72);
#pragma unroll
        for (int dt = 0; dt < 4; ++dt) { const f32x4 ov = o[qt][dt] * (inv * C8S); *(LAS unsigned*)(st + 16 * dt + 4 * gq) = pk4_fp8(clamp8(ov[0]), clamp8(ov[1]), clamp8(ov[2]), clamp8(ov[3])); }
    }
#pragma unroll
    for (int qt = 0; qt < 4; ++qt) {
        const LAS unsigned char* st = (const LAS unsigned char*)(Lq + ((wave >> 1) * 128 + qoff + 16 * qt + qi) * 72);
        *(u32x4*)(CAT + (size_t)(qrow0 + qoff + 16 * qt + qi) * DM + hq * 64 + 16 * gq) = *(const LAS u32x4*)(st + 16 * gq);
    }
}

__device__ __forceinline__ void mlstm_item(LAS unsigned char* lds, int wv_, int layer, int item) {
    const int tid = otid(wv_), lane = tid & 63, wave = __builtin_amdgcn_readfirstlane(tid >> 6), li = lane & 15, g = lane >> 4;
    const int vs = item & 3, dir = (item >> 2) & 1, h = (item >> 3) & 3, b = item >> 5;
    unsigned char* ws = ((unsigned char*)AP(ws));
    const bf16* PR = (const bf16*)(ws + WS_PR);
    const float* GATES = (const float*)(ws + WS_GATES);
    bf16* HO = (bf16*)(ws + (dir ? WS_HB : WS_HF));
    float* GS = (float*)(ws + WS_GS) + (size_t)item * 18 * 384;
    constexpr int P = 144, PV = 80, PC = 72;
    LAS bf16* Lq = (LAS bf16*)lds;
    LAS bf16* Lk = (LAS bf16*)(lds + 36864);
    LAS bf16* Lkw = (LAS bf16*)(lds + 73728);
    LAS bf16* Lv = (LAS bf16*)(lds + 110592);
    LAS bf16* LCt = (LAS bf16*)(lds + 131072);
    LAS float* A_b = (LAS float*)(lds + 149504);
    LAS float* A_a = A_b + 128; LAS float* A_cm = A_a + 128; LAS float* A_n = A_cm + 128;
    auto chunk_base = [&](int ci) -> int { return ci < 2 ? TL + b * CTXL + (dir == 0 ? ci : 1 - ci) * 128 : b * SEQ + (dir == 0 ? ci - 2 : 17 - ci) * 128; };
    __syncthreads();
    for (int ci = wave; ci < 18; ci += 8) {
        const int base = chunk_base(ci);
        float lsf[2], ig[2];
#pragma unroll
        for (int j = 0; j < 2; ++j) {
            const int tau = 2 * lane + j, row = base + (dir == 0 ? tau : 127 - tau);
            ig[j] = GATES[(size_t)row * 16 + dir * 8 + h]; const float fg = GATES[(size_t)row * 16 + dir * 8 + 4 + h];
            lsf[j] = fminf(fg, 0.f) - log1pf(__expf(-fabsf(fg)));
        }
        float sc = lsf[0] + lsf[1];
#pragma unroll
        for (int off = 1; off < 64; off <<= 1) { const float t = shup(sc, off, lane); if (lane >= off) sc += t; }
        const float b0 = (sc - (lsf[0] + lsf[1])) + lsf[0], b1 = b0 + lsf[1];
        const float a0 = ig[0] - b0, a1 = ig[1] - b1;
        float mm = fmaxf(a0, a1);
#pragma unroll
        for (int off = 1; off < 64; off <<= 1) { const float t = shup(mm, off, lane); if (lane >= off) mm = fmaxf(mm, t); }
        float mex = shup(mm, 1, lane); if (lane == 0) mex = -3.0e38f;
        const float c0 = fmaxf(mex, a0), c1 = fmaxf(c0, a1);
        float* gs = GS + ci * 384 + 2 * lane;
        *(f32x2*)(gs) = (f32x2){b0, b1}; *(f32x2*)(gs + 128) = (f32x2){a0, a1}; *(f32x2*)(gs + 256) = (f32x2){c0, c1};
    }
    if (tid < 128) A_n[tid] = 0.f;
    VM_WAIT();
    __syncthreads();
    u32x4 rq[4], rk[4], rv[2]; float rg = 0.f, r_bl, r_cl, ra[4];
#define ML_LOAD(ci_) do { const int base_ = chunk_base(ci_); \
        _Pragma("unroll") for (int j = 0; j < 4; ++j) { const int cid = tid + 512 * j, tau = cid >> 4, c = cid & 15; const size_t ro = (size_t)(base_ + (dir == 0 ? tau : 127 - tau)) * DINM; \
            rq[j] = *(const u32x4*)(PR + ro + 1536 + h * 128 + 8 * c); rk[j] = *(const u32x4*)(PR + ro + 2048 + h * 128 + 8 * c); } \
        _Pragma("unroll") for (int j = 0; j < 2; ++j) { const int cid = tid + 512 * j, tau = cid >> 3, c = cid & 7; const size_t ro = (size_t)(base_ + (dir == 0 ? tau : 127 - tau)) * DINM; \
            rv[j] = *(const u32x4*)(PR + ro + 2560 + h * 256 + vs * 64 + 8 * c); } \
        _Pragma("unroll") for (int j = 0; j < 4; ++j) ra[j] = GS[(ci_) * 384 + 128 + ((tid + 512 * j) >> 4)]; \
        if (tid < 384) rg = GS[(ci_) * 384 + tid]; r_bl = GS[(ci_) * 384 + 127]; r_cl = GS[(ci_) * 384 + 383]; } while (0)
    ML_LOAD(0);
    float m = 0.f, wcar_prev = 0.f, npart = 0.f;
    f32x4 Cacc[4]; const f32x4 zq = zero4();
#pragma unroll
    for (int vt = 0; vt < 4; ++vt) Cacc[vt] = zq;
    for (int ci = 0; ci < 18; ++ci) {
        const int base = chunk_base(ci);
        const float mprev = m, blast = r_bl, mnew = blast + fmaxf(mprev, r_cl), wcar = __expf(blast + mprev - mnew);
        __syncthreads();
        if (ci > 0 && g == 0) A_n[16 * wave + li] = wcar_prev * A_n[16 * wave + li] + npart;
        if (tid < 384) A_b[tid] = rg;
#pragma unroll
        for (int j = 0; j < 4; ++j) {
            const int cid = tid + 512 * j, tau = cid >> 4, c = cid & 15;
            *(LAS u32x4*)(Lq + tau * P + 8 * c) = rq[j];
            *(LAS u32x4*)(Lk + tau * P + 8 * c) = rk[j];
        }
#pragma unroll
        for (int j = 0; j < 2; ++j) { const int cid = tid + 512 * j, tau = cid >> 3, c = cid & 7; *(LAS u32x4*)(Lv + tau * PV + 8 * c) = rv[j]; }
#pragma unroll
        for (int vt = 0; vt < 4; ++vt) { u32x2 cw; cw.x = cvt_pk_bf16(Cacc[vt][0], Cacc[vt][1]); cw.y = cvt_pk_bf16(Cacc[vt][2], Cacc[vt][3]); *(LAS u32x2*)(LCt + (16 * wave + li) * PC + 16 * vt + 4 * g) = cw; }
#pragma unroll
        for (int j = 0; j < 4; ++j) {
            const int cid = tid + 512 * j, tau = cid >> 4, c = cid & 15;
            const float wsv = __expf(blast + ra[j] - mnew);
            const u32x4 kv = rk[j]; u32x4 kw;
            kw.x = cvt_pk_bf16(bflo(kv.x) * wsv, bfhi(kv.x) * wsv); kw.y = cvt_pk_bf16(bflo(kv.y) * wsv, bfhi(kv.y) * wsv); kw.z = cvt_pk_bf16(bflo(kv.z) * wsv, bfhi(kv.z) * wsv); kw.w = cvt_pk_bf16(bflo(kv.w) * wsv, bfhi(kv.w) * wsv);
            *(LAS u32x4*)(Lkw + tau * P + 8 * c) = kw;
        }
        if (ci + 1 < 18) ML_LOAD(ci + 1);
        LDS_WAIT();
        __syncthreads();
        bf16x8 qa[4];
#pragma unroll
        for (int kk = 0; kk < 4; ++kk) qa[kk] = *(const LAS bf16x8*)(Lq + (16 * wave + li) * P + 32 * kk + 8 * g);
        __builtin_amdgcn_s_setprio(1);
        f32x4 sT[8];
#pragma unroll
        for (int kk = 0; kk < 4; ++kk)
#pragma unroll
            for (int st = 0; st < 8; ++st) {
                const bf16x8 kb = *(const LAS bf16x8*)(Lk + (16 * st + li) * P + 32 * kk + 8 * g);
                sT[st] = __builtin_amdgcn_mfma_f32_16x16x32_bf16(kb, qa[kk], kk == 0 ? (f32x4){0.f, 0.f, 0.f, 0.f} : sT[st], 0, 0, 0);
            }
        f32x4 hT[4];
#pragma unroll
        for (int kk = 0; kk < 4; ++kk)
#pragma unroll
            for (int vt = 0; vt < 4; ++vt) {
                const LAS bf16* cp = LCt + (32 * kk + 8 * g + (li >> 2)) * PC + 16 * vt + 4 * (li & 3);
                hT[vt] = __builtin_amdgcn_mfma_f32_16x16x32_bf16(cat8(trr(cp), trr(cp + 4 * PC)), qa[kk], kk == 0 ? (f32x4){0.f, 0.f, 0.f, 0.f} : hT[vt], 0, 0, 0);
            }
        __builtin_amdgcn_s_setprio(0);
        float nq = 0.f;
#pragma unroll
        for (int kk = 0; kk < 4; ++kk) {
            const u32x4 qw = __builtin_bit_cast(u32x4, qa[kk]);
            const f32x4 n0 = *(const LAS f32x4*)(A_n + 32 * kk + 8 * g), n1 = *(const LAS f32x4*)(A_n + 32 * kk + 8 * g + 4);
            nq += bflo(qw.x) * n0[0] + bfhi(qw.x) * n0[1] + bflo(qw.y) * n0[2] + bfhi(qw.y) * n0[3] + bflo(qw.z) * n1[0] + bfhi(qw.z) * n1[1] + bflo(qw.w) * n1[2] + bfhi(qw.w) * n1[3];
        }
        nq += shx(nq, 16, lane); nq += shx(nq, 32, lane);
        const float bt = A_b[16 * wave + li], mtt = bt + fmaxf(mprev, A_cm[16 * wave + li]), wint = __expf(bt + mprev - mtt);
        float rs = 0.f;
        {
            const int dbase = 4 * g - li - 16 * wave;
            const float bm = bt - mtt;
#pragma unroll
            for (int st = 0; st < 8; ++st) {
                const f32x4 a4 = *(const LAS f32x4*)(A_a + 16 * st + 4 * g);
#pragma unroll
                for (int r = 0; r < 4; ++r) {
                    const float arg = (dbase + 16 * st + r <= 0) ? (bm + a4[r]) : -1.0e30f;
                    const float p = sT[st][r] * __expf(arg);
                    sT[st][r] = p; rs += p;
                }
            }
        }
        rs += shx(rs, 16, lane); rs += shx(rs, 32, lane);
        const float hden = 1.0f / fmaxf(fabsf(rs + wint * nq), __expf(-mtt));
#pragma unroll
        for (int vt = 0; vt < 4; ++vt) { hT[vt] = hT[vt] * wint; Cacc[vt] = Cacc[vt] * wcar; }
        {
            __builtin_amdgcn_s_setprio(1);
            bf16x8 kf[4];
#pragma unroll
            for (int kk = 0; kk < 4; ++kk) { const LAS bf16* kp = Lkw + (32 * kk + 4 * g + (li >> 2)) * P + 16 * wave + 4 * (li & 3); kf[kk] = cat8(trr(kp), trr(kp + 16 * P)); }
#pragma unroll
            for (int kk = 0; kk < 4; ++kk) {
                u32x4 pw; pw.x = cvt_pk_bf16(sT[2 * kk][0], sT[2 * kk][1]); pw.y = cvt_pk_bf16(sT[2 * kk][2], sT[2 * kk][3]); pw.z = cvt_pk_bf16(sT[2 * kk + 1][0], sT[2 * kk + 1][1]); pw.w = cvt_pk_bf16(sT[2 * kk + 1][2], sT[2 * kk + 1][3]);
                const bf16x8 pb = __builtin_bit_cast(bf16x8, pw);
#pragma unroll
                for (int vt = 0; vt < 4; ++vt) {
                    const LAS bf16* vp = Lv + (32 * kk + 4 * g + (li >> 2)) * PV + 16 * vt + 4 * (li & 3);
                    const bf16x8 vf = cat8(trr(vp), trr(vp + 16 * PV));
                    hT[vt] = __builtin_amdgcn_mfma_f32_16x16x32_bf16(vf, pb, hT[vt], 0, 0, 0);
                    Cacc[vt] = __builtin_amdgcn_mfma_f32_16x16x32_bf16(vf, kf[kk], Cacc[vt], 0, 0, 0);
                }
            }
            u32x4 on; on.x = 0x3f803f80u; on.y = 0x3f803f80u; on.z = 0x3f803f80u; on.w = 0x3f803f80u;
            f32x4 nacc = __builtin_amdgcn_mfma_f32_16x16x32_bf16(__builtin_bit_cast(bf16x8, on), kf[0], (f32x4){0.f, 0.f, 0.f, 0.f}, 0, 0, 0);
#pragma unroll
            for (int kk = 1; kk < 4; ++kk) nacc = __builtin_amdgcn_mfma_f32_16x16x32_bf16(__builtin_bit_cast(bf16x8, on), kf[kk], nacc, 0, 0, 0);
            npart = nacc[0];
            __builtin_amdgcn_s_setprio(0);
        }
        if (!(layer == 1 && ci < 2)) {
            LAS bf16* Hs = Lq + (16 * wave) * P;
#pragma unroll
            for (int vt = 0; vt < 4; ++vt) { u32x2 hw; hw.x = cvt_pk_bf16(hT[vt][0] * hden, hT[vt][1] * hden); hw.y = cvt_pk_bf16(hT[vt][2] * hden, hT[vt][3] * hden); *(LAS u32x2*)(Hs + li * P + 16 * vt + 4 * g) = hw; }
#pragma unroll
            for (int j = 0; j < 2; ++j) {
                const int cid = lane + 64 * j, tr = cid >> 3, c = cid & 7, t = 16 * wave + tr, row = base + (dir == 0 ? t : 127 - t);
                *(u32x4*)(HO + (size_t)row * 1024 + h * 256 + vs * 64 + 8 * c) = *(const LAS u32x4*)(Hs + tr * P + 8 * c);
            }
        }
        m = mnew; wcar_prev = wcar;
    }
#undef ML_LOAD
    __syncthreads();
}

__device__ __forceinline__ void phase_mlcomb(LAS unsigned char* lds, int wv_, int layer, int vcu, int G) {
    const int tid = otid(wv_), lane = tid & 63, wave = tid >> 6;
    const int nrows = layer == 0 ? TT : TL;
    unsigned char* ws = ((unsigned char*)AP(ws));
    const bf16* HF = (const bf16*)(ws + WS_HF); const bf16* HB = (const bf16*)(ws + WS_HB); const bf16* PR = (const bf16*)(ws + WS_PR);
    unsigned char* CAT = (unsigned char*)(ws + WS_CAT);
    const float* mnw = AP(mlstm_norm_w) + (size_t)layer * 1024;
    for (int it = vcu * 8 + wave; it < nrows * 4; it += G * 8) {
        const int row = it >> 2, h = it & 3, col = h * 256 + 4 * lane;
        const u32x2 f = *(const u32x2*)(HF + (size_t)row * 1024 + col), bb = *(const u32x2*)(HB + (size_t)row * 1024 + col), oo = *(const u32x2*)(PR + (size_t)row * DINM + 3584 + col);
        f32x4 s = (f32x4){bflo(f.x) + bflo(bb.x), bfhi(f.x) + bfhi(bb.x), bflo(f.y) + bflo(bb.y), bfhi(f.y) + bfhi(bb.y)};
        float ss = (s[0] * s[0] + s[1] * s[1]) + (s[2] * s[2] + s[3] * s[3]);
#pragma unroll
        for (int o = 1; o < 64; o <<= 1) ss += shx(ss, o, lane);
        const float rstd = rsqrtf(ss * (1.0f / 256.0f) + EPS);
        const f32x4 w = *(const f32x4*)(mnw + col);
        const f32x4 og = (f32x4){sigmoidf_(bflo(oo.x)), sigmoidf_(bfhi(oo.x)), sigmoidf_(bflo(oo.y)), sigmoidf_(bfhi(oo.y))};
        const f32x4 y = s * (rstd * C8S) * w * og;
        *(unsigned*)(CAT + (size_t)row * DM + 1024 + col) = pk4_fp8(clamp8(y[0]), clamp8(y[1]), clamp8(y[2]), clamp8(y[3]));
    }
}

__device__ __forceinline__ void phase_final(LAS unsigned char* lds, int wv_, int vcu, int G) {
    const int tid = otid(wv_), lane = tid & 63, wave = tid >> 6;
    unsigned char* ws = ((unsigned char*)AP(ws));
    const ETab T = build_etab(lds, wv_, (const unsigned*)(ws + WS_CTL) + CW_CNT + 32);
    const unsigned char* Y = (const unsigned char*)(ws + WS_Y);
    for (int row = vcu * 8 + wave; row < TL; row += G * 8) {
        const i32x4 te = *(const i32x4*)((const int*)(ws + WS_TOKE) + (size_t)row * 4), tp = *(const i32x4*)((const int*)(ws + WS_TOKP) + (size_t)row * 4);
        const float* g2 = (const float*)(ws + WS_MOD) + ((size_t)9 + (row >> 11)) * MODW + 5 * DM;
        size_t so[4];
#pragma unroll
        for (int k = 0; k < 4; ++k) so[k] = ((size_t)T.pbase[te[k]] * 256 + tp[k]) * DM;
        const bf16* xb = (const bf16*)(ws + WS_XB) + (size_t)row * DM;
        float* op = ((float*)AP(out)) + (size_t)row * DM;
#pragma unroll
        for (int j = 0; j < 8; ++j) {
            const int col = 4 * lane + 256 * j;
            f32x4 sum = zero4();
#pragma unroll
            for (int k = 0; k < 4; ++k) sum += up4_fp8(*(const unsigned*)(Y + so[k] + col));
            const u32x2 xw = *(const u32x2*)(xb + col);
            *(f32x4*)(op + col) = (f32x4){bflo(xw.x), bfhi(xw.x), bflo(xw.y), bfhi(xw.y)} + *(const f32x4*)(g2 + col) * (sum * Y8I);
        }
    }
}

constexpr int NPH = 18;
template <unsigned PMASK>
__global__ void __launch_bounds__(512, 2) fwd(Args a) {
    extern __shared__ __attribute__((aligned(16))) unsigned char lds_raw[];
    LAS unsigned char* lds = (LAS unsigned char*)lds_raw;
    const int wv_ = __builtin_amdgcn_readfirstlane((int)threadIdx.x >> 6);
    const int tid = otid(wv_);
    const int G = gridDim.x; const int bx = blockIdx.x;
    const int vcu = (G % 8 == 0) ? (bx % 8) * (G / 8) + bx / 8 : bx;
    volatile LAS unsigned* barw = (volatile LAS unsigned*)(lds + BARW_OFF);
    if (tid < 2) barw[tid] = 0u;
    if (tid == 64) {
        LAS unsigned long long* pt = (LAS unsigned long long*)(lds + PTAB_OFF);
        pt[SLOT_x] = (unsigned long long)a.x;
        pt[SLOT_c] = (unsigned long long)a.c;
        pt[SLOT_ctx] = (unsigned long long)a.ctx;
        pt[SLOT_c_ctx] = (unsigned long long)a.c_ctx;
        pt[SLOT_w_ada] = (unsigned long long)a.w_ada;
        pt[SLOT_b_ada] = (unsigned long long)a.b_ada;
        pt[SLOT_norm1_w] = (unsigned long long)a.norm1_w;
        pt[SLOT_norm2_w] = (unsigned long long)a.norm2_w;
        pt[SLOT_w_in] = (unsigned long long)a.w_in;
        pt[SLOT_b_gates] = (unsigned long long)a.b_gates;
        pt[SLOT_q_norm_w] = (unsigned long long)a.q_norm_w;
        pt[SLOT_k_norm_w] = (unsigned long long)a.k_norm_w;
        pt[SLOT_attn_sink] = (unsigned long long)a.attn_sink;
        pt[SLOT_mlstm_norm_w] = (unsigned long long)a.mlstm_norm_w;
        pt[SLOT_w_out] = (unsigned long long)a.w_out;
        pt[SLOT_w_router] = (unsigned long long)a.w_router;
        pt[SLOT_b_router] = (unsigned long long)a.b_router;
        pt[SLOT_w_gate_up] = (unsigned long long)a.w_gate_up;
        pt[SLOT_b_gate_up] = (unsigned long long)a.b_gate_up;
        pt[SLOT_w_down] = (unsigned long long)a.w_down;
        pt[SLOT_b_down] = (unsigned long long)a.b_down;
        pt[SLOT_out] = (unsigned long long)a.out;
        pt[SLOT_ws] = (unsigned long long)a.ws;
    }
    __syncthreads();
    unsigned char* ws0 = (unsigned char*)AP(ws);
    XcdBarrier bar; bar.bar = (unsigned*)(ws0 + WS_CTL) + CW_BAR; bar.x = 0; bar.st = barw; bar.wv = wv_;
    const bool multi = (a.ph_hi - a.ph_lo) > 1;
    if (multi) bar = xcd_barrier_post((unsigned*)(ws0 + WS_CTL) + CW_BAR, barw, wv_);
    const int lo = a.ph_lo, hi = a.ph_hi;
#define PH_MASK PMASK
#define IN(k) (lo <= (k) && (k) < hi)
#define INL(j) (((PH_MASK >> ((j) + 1)) & 1) && IN(pb + (j)))
#define SEAM(k) do { if (IN(k) && IN((k) + 1)) xcd_barrier(bar); } while (0)
#define REP(t) for (int rep_ = 0; rep_ < (((DUP_MASK >> (t)) & 1u) ? 2 : 1); ++rep_, (rep_ < (((DUP_MASK >> (t)) & 1u) ? 2 : 1) && multi) ? xcd_barrier(bar) : (void)0)
    if ((PH_MASK & 1) && IN(0)) { REP(0) phase_prologue(lds, wv_, opqi(vcu), opqi(G)); }
    SEAM(0);
#pragma unroll
    for (int layer = 0; layer < DEPTH; ++layer) {
        const int pb = 1 + 8 * layer;
        const int Mrows = layer == 0 ? TT : TL;
        if (INL(0)) {
            if (layer == 0) {
                const int first = opqi(vcu) & 1;
#pragma clang loop unroll(disable)
                for (int stg = 0; stg < 2; ++stg) {
                    if ((stg ^ first) == 0) phase_norm<false, false, false>(lds, wv_, layer, opqi(vcu), opqi(G));
                    else conv_static(lds, wv_, 0, CV_NPJ, opqi(vcu), opqi(G));
                }
            } else phase_norm<false, true, true>(lds, wv_, layer, opqi(vcu), opqi(G));
        }
        SEAM(pb + 0);
        if (INL(1)) REP(2) {
            unsigned char* ws = ((unsigned char*)AP(ws));
            SrcDense8 S; S.A = (const char*)(ws + WS_HX); S.Bt = (const char*)(ws + WS_WIN) + (size_t)layer * DINM * DM; S.K = DM;
            gm::InProjOrder O; O.init(opqi(G), opqi(bx), layer == 0 ? 1 : 0);
            LAS float* ec = (LAS float*)(lds + EC_OFF);
            { const int tid = otid(wv_); __syncthreads();
              for (int i = tid; i < 2176; i += 512) ec[i] = i < 2048 ? ((const float*)(ws + WS_ROPE))[i] : (i < 2112 ? AP(q_norm_w)[layer * 64 + i - 2048] : AP(k_norm_w)[layer * 64 + i - 2112]);
              __syncthreads(); }
            EpiInProj E; E.PR = (bf16*)(ws + WS_PR); E.ec = ec;
            gm::gemm_phase(lds, wv_, S, O, E);
            conv_fill(lds, wv_, layer == 0 ? 0 : 3, opqi(bx), opqi(vcu), opqi(G));
        }
        SEAM(pb + 1);
        if (INL(2)) REP(3) {
            const int grp = opqi(vcu) & 3;
#pragma clang loop unroll(disable)
            for (int stg = 0; stg < 3; ++stg) {
                const int what = grp == 0 ? stg : (grp == 1 ? (stg == 0 ? 1 : (stg == 1 ? 0 : 2)) : (grp == 2 ? (stg == 0 ? 2 : (stg == 1 ? 0 : 1)) : 2 - stg));
                if (what == 0) conv_static(lds, wv_, CV_G0 + layer * (CV_N_GU / 2), CV_N_GU / 2, opqi(vcu), opqi(G));
                else if (what == 1) {
                    for (int it = opqi(vcu), Gm = opqi(G); it < 256; it += Gm) mlstm_item(lds, wv_, layer, it);
                } else {
                    const int nlat = NB * 16 * 4, nctx = layer == 0 ? NB * 2 * 4 : 0;
                    for (int it = opqi(vcu), Ga = opqi(G); it < nlat + nctx; it += Ga) {
                        int ab, an, ah, ag;
                        if (it < nlat) { ab = it >> 6; an = (it >> 2) & 15; ah = 0; ag = it & 3; }
                        else { const int j = it - nlat; ab = j >> 3; an = -1; ah = (j >> 2) & 1; ag = j & 3; }
                        attn_unit(lds, wv_, layer, ab, an, ah, ag);
                    }
                }
            }
            if (layer == 0) conv_fill(lds, wv_, 1, opqi(bx), opqi(vcu), opqi(G));
        }
        SEAM(pb + 2);
        if (INL(3)) { REP(4) phase_mlcomb(lds, wv_, layer, opqi(vcu), opqi(G)); }
        SEAM(pb + 3);
        if (INL(4)) REP(5) {
            unsigned char* ws = ((unsigned char*)AP(ws));
            SrcDense8 S; S.A = (const char*)(ws + WS_CAT); S.Bt = (const char*)(ws + WS_WOUT) + (size_t)layer * DM * DM; S.K = DM;
            gm::StaticOrder O; O.init(Mrows / 256, DM / 256, opqi(G), opqi(bx));
            EpiOutProj E; E.baseLat = AP(x); E.baseCtx = AP(ctx); E.baseB = layer == 0 ? (const bf16*)nullptr : (const bf16*)(ws + WS_XA);
            E.outp = (bf16*)(ws + WS_XB); E.g1 = (const float*)(ws + WS_MOD) + (size_t)layer * 9 * MODW + 2 * DM; E.wvi = wv_;
            gm::gemm_phase(lds, wv_, S, O, E);
            if (layer == 0) conv_fill(lds, wv_, 2, opqi(bx), opqi(vcu), opqi(G));
        }
        SEAM(pb + 4);
        if (INL(5)) {
            if (layer != DEPTH - 1) {
                const int first = opqi(vcu) & 1;
#pragma clang loop unroll(disable)
                for (int stg = 0; stg < 2; ++stg) {
                    if ((stg ^ first) == 0) phase_norm<true, false, true>(lds, wv_, layer, opqi(vcu), opqi(G));
                    else if (layer == 0) conv_static(lds, wv_, CV_D0, CV_N_D / 2, opqi(vcu), opqi(G));
                }
            } else {
                const int first = opqi(vcu) & 1;
#pragma clang loop unroll(disable)
                for (int stg = 0; stg < 2; ++stg) {
                    if ((stg ^ first) == 0) phase_norm<true, false, true>(lds, wv_, layer, opqi(vcu), opqi(G));
                    else conv_drain(lds, wv_, opqi(bx), opqi(vcu), opqi(G));
                }
            }
        }
        SEAM(pb + 5);
        if (INL(6)) REP(7) {
            unsigned char* ws = ((unsigned char*)AP(ws));
            const ETab T = build_etab(lds, wv_, (const unsigned*)(ws + WS_CTL) + CW_CNT + 32 * layer);
            LAS int* ec = (LAS int*)(lds + EC_OFF);
            SrcGateUp S; S.A = (const char*)(ws + WS_HX); S.Bt = (const char*)(ws + WS_WGU) + (size_t)layer * NEXP * 2048 * DM; S.ec = ec; S.T = T; S.K = DM;
            gm::StaticOrder O; O.init(T.pbase[NEXP], 8, opqi(G), opqi(bx));
            { const int* idxl = (const int*)(ws + WS_IDXL); const float* bgu = AP(b_gate_up) + (size_t)layer * NEXP * 2048;
              ec_preload(wv_, O, [&](int i, const gm::Unit& u, int tid) {
                  const int e = T.pe[u.pm], lp = u.pm - T.pbase[e], ne = T.cnt[e];
                  if (tid < 256) { const int li = lp * 256 + tid; ec[i * 512 + tid] = li < ne ? idxl[(size_t)e * TT + li] : 0; }
                  else { const int t = tid - 256; ((LAS float*)ec)[i * 512 + 256 + t] = bgu[(size_t)e * 2048 + (t >> 7) * 1024 + 128 * u.pn + (t & 127)]; } }); }
            EpiGateUp E; E.H = (bf16*)(ws + WS_H); E.ec = (const LAS float*)ec; E.T = T;
            gm::gemm_phase(lds, wv_, S, O, E);
        }
        SEAM(pb + 6);
        if (INL(7)) REP(8) {
            unsigned char* ws = ((unsigned char*)AP(ws));
            const ETab T = build_etab(lds, wv_, (const unsigned*)(ws + WS_CTL) + CW_CNT + 32 * layer);
            SrcDown S; S.A = (const char*)(ws + WS_H); S.Bt = (const char*)(ws + WS_WD) + (size_t)layer * NEXP * DM * DFF; S.T = T; S.K = DFF;
            gm::StaticOrder O; O.init(T.pbase[NEXP], 8, opqi(G), opqi(bx));
            LAS float* ec = (LAS float*)(lds + EC_OFF);
            { const float* bd = AP(b_down) + (size_t)layer * NEXP * DM; const float* WL = (const float*)(ws + WS_WL);
              ec_preload(wv_, O, [&](int i, const gm::Unit& u, int tid) {
                  const int e = T.pe[u.pm], lp = u.pm - T.pbase[e], ne = T.cnt[e];
                  if (tid < 256) ec[i * 512 + tid] = bd[(size_t)e * DM + 256 * u.pn + tid];
                  else { const int li = lp * 256 + tid - 256; ec[i * 512 + tid] = li < ne ? WL[(size_t)e * TT + li] : 0.0f; } }); }
            EpiDown E; E.Y = (bf16*)(ws + WS_Y); E.ec = ec; E.T = T;
            gm::gemm_phase(lds, wv_, S, O, E);
        }
        SEAM(pb + 7);
    }
    if (((PH_MASK >> 17) & 1) && IN(17)) { REP(17) phase_final(lds, wv_, opqi(vcu), opqi(G)); }
#undef IN
#undef INL
#undef SEAM
#undef REP
#undef PH_MASK
}

typedef void (*kern_t)(Args);
#if MK_ONE_LAUNCH
static kern_t g_kern[1] = { fwd<0x3ffffu> };
#else
static kern_t g_kern[10] = { fwd<1u << 0>, fwd<1u << 1>, fwd<1u << 2>, fwd<1u << 3>, fwd<1u << 4>, fwd<1u << 5>, fwd<1u << 6>, fwd<1u << 7>, fwd<1u << 8>, fwd<1u << 17> };
#endif
extern "C" void kernel_launch(void* const* d_in, const int* in_sizes, int n_in, void* d_out, int out_size, void* d_ws, size_t ws_size, hipStream_t stream) {
    static int grid = 0;
    constexpr int NK = (int)(sizeof(g_kern) / sizeof(g_kern[0]));
    if (grid == 0) {
        if (n_in != 21 || out_size != TL * DM || ws_size < WS_END) { fprintf(stderr, "kernel_launch: unexpected problem (n_in %d, out %d, ws %zu)\n", n_in, out_size, ws_size); grid = -1; return; }
        int dev = 0, cus = 0;
        if (hipGetDevice(&dev) != hipSuccess || hipDeviceGetAttribute(&cus, hipDeviceAttributeMultiprocessorCount, dev) != hipSuccess) { grid = -1; return; }
        for (int k = 0; k < NK; ++k)
            if (hipFuncSetAttribute((const void*)g_kern[k], hipFuncAttributeMaxDynamicSharedMemorySize, LDS_BYTES) != hipSuccess) { fprintf(stderr, "kernel_launch: hipFuncSetAttribute failed\n"); grid = -1; return; }
        int per_cu = 0;
        if (hipOccupancyMaxActiveBlocksPerMultiprocessor(&per_cu, (const void*)g_kern[0], 512, LDS_BYTES) != hipSuccess || per_cu < 1) { fprintf(stderr, "kernel_launch: occupancy query says %d\n", per_cu); }
        (void)hipGetLastError();
        grid = cus;
    }
    if (grid < 0) return;
    (void)hipMemsetAsync((char*)d_ws + WS_CTL, 0, CTL_BYTES, stream);
    Args a{};
    const float** p = (const float**)&a;
    for (int i = 0; i < 21; ++i) p[i] = (const float*)d_in[i];
    a.out = (float*)d_out; a.ws = (unsigned char*)d_ws;
#if MK_ONE_LAUNCH
    a.ph_lo = 0; a.ph_hi = NPH;
    hipLaunchKernelGGL(g_kern[0], dim3(grid), dim3(512), LDS_BYTES, stream, a);
#else
    for (int ph = 0; ph < NPH; ++ph) {
        a.ph_lo = ph; a.ph_hi = ph + 1;
        const int t = ph == 0 ? 0 : (ph == NPH - 1 ? 9 : (ph - 1) % 8 + 1);
        hipLaunchKernelGGL(g_kern[t], dim3(grid), dim3(512), LDS_BYTES, stream, a);
    }
#endif
}
```

```cpp
#include <hip/hip_runtime.h>
#include <cstdio>
#include <cstdint>

#ifndef DUP_MASK
#define DUP_MASK 0u
#endif
#ifndef DUP_ATT
#define DUP_ATT 0
#endif
#ifndef DUP_ML
#define DUP_ML 0
#endif
#ifndef MK_ONE_LAUNCH
#define MK_ONE_LAUNCH 1
#endif

#define LAS __attribute__((address_space(3)))
#define GAS __attribute__((address_space(1)))
typedef unsigned short bf16;
typedef short bf16x8 __attribute__((ext_vector_type(8)));
typedef short bf16x4 __attribute__((ext_vector_type(4)));
typedef float f32x4 __attribute__((ext_vector_type(4)));
typedef float f32x2 __attribute__((ext_vector_type(2)));
typedef unsigned u32x4 __attribute__((ext_vector_type(4)));
typedef unsigned u32x2 __attribute__((ext_vector_type(2)));
typedef int i32x4 __attribute__((ext_vector_type(4)));

constexpr int NB = 8, SEQ = 2048, DM = 2048, CTXL = 256, DEPTH = 2;
constexpr int TL = NB * SEQ, TC = NB * CTXL, TT = TL + TC;
constexpr int DIN = 4624, DINM = 4608, NEXP = 32, DFF = 1024, MODW = 6 * DM;
constexpr int MAXPANEL = 320, MAXSLOT = MAXPANEL * 256;
constexpr float EPS = 1e-6f;
constexpr float LOG2E = 1.4426950408889634f;

constexpr size_t MiB = 1u << 20;
constexpr size_t WS_CTL = 0, CTL_BYTES = 1 * MiB;
constexpr size_t WS_ROPE = 1 * MiB;
constexpr size_t WS_WGP = 2 * MiB;
constexpr size_t WS_WRP = 3 * MiB;
constexpr size_t WS_MOD = 4 * MiB;
constexpr size_t WS_GATES = 5 * MiB;
constexpr size_t WS_TOKE = 7 * MiB;
constexpr size_t WS_TOKP = 8 * MiB;
constexpr size_t WS_IDXL = 9 * MiB;
constexpr size_t WS_WL = 12 * MiB;
constexpr size_t WS_WIN = 16 * MiB;
constexpr size_t WS_WOUT = 52 * MiB;
constexpr size_t WS_WGU = 68 * MiB;
constexpr size_t WS_WD = 580 * MiB;
constexpr size_t WS_HX = 836 * MiB;
constexpr size_t WS_PR = 908 * MiB;
constexpr size_t WS_HF = 1070 * MiB;
constexpr size_t WS_HB = 1106 * MiB;
constexpr size_t WS_CAT = 1142 * MiB;
constexpr size_t WS_XB = 1214 * MiB;
constexpr size_t WS_XA = 1358 * MiB;
constexpr size_t WS_H = 1502 * MiB;
constexpr size_t WS_Y = 1662 * MiB;
constexpr size_t WS_GS = 1982 * MiB;
constexpr size_t WS_END = 1990 * MiB;
constexpr int CW_CNT = 64;
constexpr int CW_BAR = 4096;
constexpr int CW_CQ = 256;
constexpr int CW_TD = 320;

constexpr int LDS_BYTES = 163840;
constexpr int TBL_OFF = 161280;
constexpr int EC_OFF = 131072;
constexpr int EC_MAXU = 14;
constexpr int BARW_OFF = LDS_BYTES - 64;

struct Args {
    const float *x, *c, *ctx, *c_ctx, *w_ada, *b_ada, *norm1_w, *norm2_w, *w_in, *b_gates, *q_norm_w, *k_norm_w, *attn_sink, *mlstm_norm_w,
                *w_out, *w_router, *b_router, *w_gate_up, *b_gate_up, *w_down, *b_down;
    float* out; unsigned char* ws; int ph_lo, ph_hi;
};

enum { SLOT_x = 0, SLOT_c = 1, SLOT_ctx = 2, SLOT_c_ctx = 3, SLOT_w_ada = 4, SLOT_b_ada = 5, SLOT_norm1_w = 6, SLOT_norm2_w = 7, SLOT_w_in = 8, SLOT_b_gates = 9, SLOT_q_norm_w = 10, SLOT_k_norm_w = 11, SLOT_attn_sink = 12, SLOT_mlstm_norm_w = 13, SLOT_w_out = 14, SLOT_w_router = 15, SLOT_b_router = 16, SLOT_w_gate_up = 17, SLOT_b_gate_up = 18, SLOT_w_down = 19, SLOT_b_down = 20, SLOT_out = 21, SLOT_ws = 22 };
constexpr int PTAB_OFF = LDS_BYTES - 512;
template <class T> __device__ __forceinline__ T* ldp(LAS unsigned char* lds, int slot) {
    const unsigned long long v = *(const LAS unsigned long long*)(lds + PTAB_OFF + 8 * slot);
    const unsigned lo = __builtin_amdgcn_readfirstlane((unsigned)v), hi = __builtin_amdgcn_readfirstlane((unsigned)(v >> 32));
    return (T*)(GAS T*)(((unsigned long long)hi << 32) | lo);
}
#define AP(f) ldp<const float>(lds, SLOT_##f)

__device__ __forceinline__ unsigned f2bf(float f) { unsigned u = __float_as_uint(f); return (u + 0x7fffu + ((u >> 16) & 1u)) >> 16; }
__device__ __forceinline__ unsigned pk2(float lo, float hi) { return f2bf(lo) | (f2bf(hi) << 16); }
__device__ __forceinline__ float bf2f(unsigned b) { return __uint_as_float(b << 16); }
__device__ __forceinline__ float bflo(unsigned w) { return __uint_as_float(w << 16); }
__device__ __forceinline__ float bfhi(unsigned w) { return __uint_as_float(w & 0xffff0000u); }
__device__ __forceinline__ unsigned cvt_pk_bf16(float lo, float hi) { unsigned r; asm volatile("v_cvt_pk_bf16_f32 %0, %1, %2" : "=v"(r) : "v"(lo), "v"(hi)); return r; }
__device__ __forceinline__ float sigmoidf_(float z) { return __builtin_amdgcn_rcpf(1.0f + __expf(-z)); }
__device__ __forceinline__ int otid(int wv) { int l; asm volatile("v_mbcnt_lo_u32_b32 %0, -1, 0\n\tv_mbcnt_hi_u32_b32 %0, -1, %0" : "=v"(l)); return (wv << 6) | l; }
__device__ __forceinline__ float shx(float v, int m, int lane) { return __int_as_float(__builtin_amdgcn_ds_bpermute((lane ^ m) << 2, __float_as_int(v))); }
__device__ __forceinline__ float shup(float v, int off, int lane) { return __int_as_float(__builtin_amdgcn_ds_bpermute(((lane - off) & 63) << 2, __float_as_int(v))); }
__device__ __forceinline__ int opqi(int v) { asm volatile("" : "+s"(v)); return v; }
__device__ __forceinline__ unsigned char* opq(unsigned char* p) { unsigned z = 0; asm volatile("" : "+s"(z)); return p + z; }
__device__ __forceinline__ f32x4 zero4() {
    float a, b, c, d; asm volatile("v_mov_b32 %0, 0\n\tv_mov_b32 %1, 0\n\tv_mov_b32 %2, 0\n\tv_mov_b32 %3, 0" : "=v"(a), "=v"(b), "=v"(c), "=v"(d)); return (f32x4){a, b, c, d}; }
__device__ __forceinline__ unsigned pk4_fp8(float a, float b, float c, float d) { int w = __builtin_amdgcn_cvt_pk_fp8_f32(a, b, 0, false); w = __builtin_amdgcn_cvt_pk_fp8_f32(c, d, w, true); return (unsigned)w; }
__device__ __forceinline__ float clamp8(float v) { return fminf(fmaxf(v, -448.0f), 448.0f); }
__device__ __forceinline__ f32x4 up4_fp8(unsigned w) { const f32x2 a = __builtin_amdgcn_cvt_pk_f32_fp8((int)w, false), b = __builtin_amdgcn_cvt_pk_f32_fp8((int)w, true); return (f32x4){a[0], a[1], b[0], b[1]}; }
constexpr float Y8S = 16.0f, Y8I = 0.0625f;
constexpr float C8S = 16.0f, C8I = 0.0625f;
constexpr float W8S = 32.0f, W8I = 0.03125f;
#define LDS_WAIT() asm volatile("s_waitcnt lgkmcnt(0)" ::: "memory")
#define VM_WAIT() asm volatile("s_waitcnt vmcnt(0)" ::: "memory")

namespace gm {
constexpr int BM = 256, BK = 64, HALF = 128, HTB = HALF * BK * 2, STAGE_BYTES = 8 * HTB, NXCD = 8, WGM = 8;
__host__ __device__ __forceinline__ int lds_byte(int r, int c) { const int st = (r >> 4) * 2 + (c >> 5), rr = r & 15, cc = c & 31, ob = rr * 64 + cc * 2; return st * 1024 + (ob ^ (((ob >> 9) & 1) << 5)); }
__host__ __device__ __forceinline__ void stage_rc(int b, int& R, int& C) { const int st = b / 1024, sb = b % 1024, swz = sb ^ (((sb >> 9) & 1) << 5); R = (st >> 1) * 16 + swz / 64; C = (st & 1) * 32 + (swz % 64) / 2; }
__host__ __device__ __forceinline__ int perm32(int rho) { const int n = rho >> 4, i = rho & 15; return 8 * (i >> 2) + 4 * n + (i & 3); }
struct Unit { int pm, pn; };
typedef int v8i_t __attribute__((ext_vector_type(8)));
__device__ __forceinline__ v8i_t cat8i(bf16x8 a, bf16x8 b) { const u32x4 x = __builtin_bit_cast(u32x4, a), y = __builtin_bit_cast(u32x4, b); v8i_t r; r[0] = (int)x.x; r[1] = (int)x.y; r[2] = (int)x.z; r[3] = (int)x.w; r[4] = (int)y.x; r[5] = (int)y.y; r[6] = (int)y.z; r[7] = (int)y.w; return r; }
struct InProjOrder {
    int G, c, full;
    __device__ void init(int G_, int c_, int full_) { G = G_; c = c_; full = full_; }
    __device__ bool next(int i, Unit& u) const {
        const int nlat = 64 * 18, nwg = full ? 72 * 18 : nlat + 8 * 8;
        const long L = (long)i * G + c; if (L >= nwg) return false;
        int wgid = (int)L;
        if (!full && wgid >= nlat) { const int r = wgid - nlat, t = r & 7; u.pm = 64 + (r >> 3); u.pn = t < 2 ? 4 + t : 6 + t; return true; }
        const int nM = full ? 72 : 64, nN = 18, nw2 = nM * nN;
        { const int q = nw2 / NXCD, r = nw2 % NXCD, xcd = wgid % NXCD, off = wgid / NXCD; wgid = (xcd < r ? xcd * (q + 1) : r * (q + 1) + (xcd - r) * q) + off; }
        const int nig = WGM * nN, gid = wgid / nig, fm = gid * WGM, gsz = (nM - fm) < WGM ? (nM - fm) : WGM;
        u.pm = fm + ((wgid % nig) % gsz); u.pn = (wgid % nig) / gsz; return true;
    }
};
struct StaticOrder {
    int nM, nN, nwg, G, c;
    __device__ void init(int nM_, int nN_, int G_, int c_) { nM = nM_; nN = nN_; nwg = nM * nN; G = G_; c = c_; }
    __device__ bool next(int i, Unit& u) const {
        const long L = (long)i * G + c; if (L >= nwg) return false;
        int wgid = (int)L; { const int q = nwg / NXCD, r = nwg % NXCD, xcd = wgid % NXCD, off = wgid / NXCD; wgid = (xcd < r ? xcd * (q + 1) : r * (q + 1) + (xcd - r) * q) + off; }
        const int nig = WGM * nN, gid = wgid / nig, fm = gid * WGM, gsz = (nM - fm) < WGM ? (nM - fm) : WGM;
        u.pm = fm + ((wgid % nig) % gsz); u.pn = (wgid % nig) / gsz; return true;
    }
};

template <class Src, class Epi, class Sched>
__device__ __forceinline__ void gemm_phase(LAS unsigned char* lds, int wv_, const Src& G, const Sched& S, const Epi& E) {
    const int tid = otid(wv_), wid = __builtin_amdgcn_readfirstlane(tid >> 6), lane = tid & 63, wr = wid >> 2, wc = wid & 3, fr = lane & 15, fq = lane >> 4;
    constexpr bool FP8 = Src::FP8;
    const int KB = FP8 ? G.K : G.K * 2, nt = KB / 128;
    unsigned voffB[2];
#pragma unroll
    for (int i = 0; i < 2; ++i) { int R, C; stage_rc(tid * 16 + i * 8192, R, C); voffB[i] = (unsigned)(R * KB + 2 * C); }
    const size_t hstepB = (size_t)HALF * KB;
    const size_t hstepA = Src::GATHER ? 0 : hstepB;
    const unsigned ldsw = (unsigned)wid * 1024u;
    const int aoff = lds_byte(wr * 64 + fr, fq * 8), boff = lds_byte(wc * 32 + fr, fq * 8);
    constexpr int FD = 1024;
#define PG8_SA(b, h) (((b) * 2 + (h)) * HTB)
#define PG8_SB(b, h) ((4 + (b) * 2 + (h)) * HTB)
#define PG8_STAGE_B(bufoff, gbase) do { _Pragma("unroll") for (int _i = 0; _i < 2; ++_i) \
        __builtin_amdgcn_global_load_lds((const unsigned*)((const char*)(gbase) + voffB[_i]), (LAS unsigned*)(lds + (bufoff) + ldsw + _i * 8192), 16, 0, 0); } while (0)
#define PG8_STAGE_A(bufoff, h, kbyte) do { const char* _ap = Ab + (size_t)(kbyte) + (size_t)(h) * hstepA; _Pragma("unroll") for (int _i = 0; _i < 2; ++_i) \
        __builtin_amdgcn_global_load_lds((const unsigned*)(_ap + va[Src::GATHER ? (h) : 0][_i]), (LAS unsigned*)(lds + (bufoff) + ldsw + _i * 8192), 16, 0, 0); } while (0)
#define PG8_LDA(dst, b, h) do { _Pragma("unroll") for (int m = 0; m < 4; ++m) _Pragma("unroll") for (int k = 0; k < 2; ++k) dst[m][k] = *(const LAS bf16x8*)(lds + PG8_SA(b, h) + aoff + m * 2048 + k * FD); } while (0)
#define PG8_LDB(dst, b, h) do { _Pragma("unroll") for (int n = 0; n < 2; ++n) _Pragma("unroll") for (int k = 0; k < 2; ++k) dst[n][k] = *(const LAS bf16x8*)(lds + PG8_SB(b, h) + boff + n * 2048 + k * FD); } while (0)
#define PG8_MMA(ai, bj, At, Bt) do { __builtin_amdgcn_s_setprio(1); _Pragma("unroll") for (int m = 0; m < 4; ++m) _Pragma("unroll") for (int n = 0; n < 2; ++n) { \
        if constexpr (FP8) acc[ai][bj][m][n] = __builtin_amdgcn_mfma_scale_f32_16x16x128_f8f6f4(cat8i(Bt[n][0], Bt[n][1]), cat8i(At[m][0], At[m][1]), acc[ai][bj][m][n], 0, 0, 0, 0x7f7f7f7f, 0, 0x7f7f7f7f); \
        else { _Pragma("unroll") for (int k = 0; k < 2; ++k) acc[ai][bj][m][n] = __builtin_amdgcn_mfma_f32_16x16x32_bf16(Bt[n][k], At[m][k], acc[ai][bj][m][n], 0, 0, 0); } } \
        __builtin_amdgcn_s_setprio(0); } while (0)
#define PG8_WAIT_V(n) asm volatile("s_waitcnt vmcnt(" #n ")" ::: "memory")
#define PG8_WAIT_L(n) asm volatile("s_waitcnt lgkmcnt(" #n ")" ::: "memory")
#define PG8_BAR __builtin_amdgcn_s_barrier()
#define PG8_SCHED __builtin_amdgcn_sched_barrier(0)
    Unit cur, nxt; int ui = 0;
    if (!S.next(0, cur)) return;
    f32x4 acc[2][2][4][2];
    const f32x4 zq = zero4();
#pragma unroll
    for (int a = 0; a < 2; ++a)
#pragma unroll
        for (int b = 0; b < 2; ++b)
#pragma unroll
            for (int m = 0; m < 4; ++m)
#pragma unroll
                for (int n = 0; n < 2; ++n) acc[a][b][m][n] = zq;
    bf16x8 At[4][2], B0[2][2], B1[2][2];
    unsigned va[Src::GATHER ? 2 : 1][2];
    G.aoff(cur, tid, va, 0);
    const char* const Ab = G.abase();
    const char* cB = G.bptr(cur);
    const unsigned kstep = BK * 2;
    PG8_STAGE_B(PG8_SB(0, 0), cB); PG8_STAGE_B(PG8_SB(0, 1), cB + hstepB); PG8_STAGE_A(PG8_SA(0, 0), 0, 0u); PG8_STAGE_A(PG8_SA(0, 1), 1, 0u);
    if (wr == 1) PG8_BAR;
    PG8_WAIT_V(2); PG8_BAR;
    PG8_STAGE_B(PG8_SB(1, 0), cB + kstep); PG8_STAGE_A(PG8_SA(1, 0), 0, kstep); PG8_STAGE_B(PG8_SB(1, 1), cB + hstepB + kstep);
    PG8_WAIT_V(6); PG8_BAR;
    for (;;) {
        const bool has_next = S.next(ui + 1, nxt);
        const char* nB = cB;
        for (int t = 0; t < nt; t += 2) {
            const bool last = (t == nt - 2);
            PG8_STAGE_A(PG8_SA(1, 1), 1, (unsigned)(t + 1) * kstep); PG8_SCHED; PG8_LDB(B0, 0, 0); PG8_LDB(B1, 0, 1); PG8_SCHED; PG8_LDA(At, 0, 0);
            PG8_WAIT_V(8); PG8_WAIT_L(0); PG8_BAR; PG8_MMA(0, 0, At, B0); PG8_MMA(0, 1, At, B1); PG8_BAR; PG8_SCHED;
            const char* b2; unsigned k2;
            if (last) { if (has_next) { G.aoff(nxt, tid, va, ui + 1); nB = G.bptr(nxt); } b2 = nB; k2 = 0u; }
            else { b2 = cB + (size_t)(t + 2) * kstep; k2 = (unsigned)(t + 2) * kstep; }
            PG8_STAGE_B(PG8_SB(0, 0), b2); PG8_STAGE_B(PG8_SB(0, 1), b2 + hstepB); PG8_STAGE_A(PG8_SA(0, 0), 0, k2); PG8_SCHED; PG8_LDA(At, 0, 1);
            PG8_WAIT_V(8); PG8_WAIT_L(0); PG8_BAR; PG8_MMA(1, 0, At, B0); PG8_MMA(1, 1, At, B1); PG8_BAR; PG8_SCHED;
            PG8_STAGE_A(PG8_SA(0, 1), 1, k2); PG8_SCHED; PG8_LDB(B0, 1, 0); PG8_LDB(B1, 1, 1); PG8_SCHED; PG8_LDA(At, 1, 0);
            PG8_WAIT_V(8); PG8_WAIT_L(0); PG8_BAR; PG8_MMA(0, 0, At, B0); PG8_MMA(0, 1, At, B1); PG8_BAR; PG8_SCHED;
            PG8_STAGE_B(PG8_SB(1, 0), b2 + kstep); PG8_STAGE_B(PG8_SB(1, 1), b2 + hstepB + kstep); PG8_STAGE_A(PG8_SA(1, 0), 0, k2 + kstep); PG8_SCHED; PG8_LDA(At, 1, 1);
            PG8_WAIT_V(8); PG8_WAIT_L(0); PG8_BAR; PG8_MMA(1, 0, At, B0); PG8_MMA(1, 1, At, B1); PG8_BAR; PG8_SCHED;
        }
        if (wr == 0) PG8_BAR;
        E(acc, cur, wr, wc, fr, fq, ui);
        if (!has_next) break;
        const f32x4 zq2 = zero4();
#pragma unroll
        for (int a = 0; a < 2; ++a)
#pragma unroll
            for (int b = 0; b < 2; ++b)
#pragma unroll
                for (int m = 0; m < 4; ++m)
#pragma unroll
                    for (int n = 0; n < 2; ++n) acc[a][b][m][n] = zq2;
        cur = nxt; cB = nB; ++ui;
        if (wr == 1) PG8_BAR;
    }
    PG8_WAIT_V(0);
    PG8_BAR;
#undef PG8_SA
#undef PG8_SB
#undef PG8_STAGE_A
#undef PG8_STAGE_B
#undef PG8_LDA
#undef PG8_LDB
#undef PG8_MMA
#undef PG8_WAIT_V
#undef PG8_WAIT_L
#undef PG8_BAR
#undef PG8_SCHED
}
}

struct ETab { const LAS int* pe; const LAS int* pbase; const LAS int* cnt; };
__device__ __forceinline__ ETab build_etab(LAS unsigned char* lds, int wv_, const unsigned* gcnt) {
    LAS int* pe = (LAS int*)(lds + TBL_OFF); LAS int* pbase = pe + 384; LAS int* cnt = pbase + 40;
    const int tid = otid(wv_);
    __syncthreads();
    if (tid < 32) cnt[tid] = (int)gcnt[tid];
    __syncthreads();
    if (tid == 0) { int p = 0;
#pragma clang loop unroll(disable) vectorize(disable)
        for (int e = 0; e < NEXP; ++e) { pbase[e] = p; p += (cnt[e] + 255) >> 8; }
        pbase[NEXP] = p; }
    __syncthreads();
    if (tid < 384) { int e = 0;
#pragma clang loop unroll(disable) vectorize(disable)
        for (int j = 1; j <= NEXP; ++j) e += (pbase[j] <= tid) ? 1 : 0;
        pe[tid] = e < NEXP ? e : NEXP - 1; }
    __syncthreads();
    ETab t; t.pe = pe; t.pbase = pbase; t.cnt = cnt; return t;
}

template <class Sched, class F>
__device__ __forceinline__ void ec_preload(int wv_, const Sched& S, F&& fill) {
    const int tid = otid(wv_);
    __syncthreads();
    gm::Unit u;
    for (int i = 0; i < EC_MAXU && S.next(i, u); ++i) fill(i, u, tid);
    __syncthreads();
}
struct SrcDense {
    const char* A; const char* Bt; int K;
    __device__ __forceinline__ const char* abase() const { return A; }
    __device__ __forceinline__ const char* bptr(const gm::Unit& u) const { return Bt + (size_t)u.pn * 256 * K * 2; }
    static constexpr bool GATHER = false, FP8 = false;
    __device__ __forceinline__ void aoff(const gm::Unit& u, int tid, unsigned (&va)[1][2], int) const {
        asm volatile("" : "+v"(tid));
#pragma unroll
        for (int i = 0; i < 2; ++i) { int R, C; gm::stage_rc(tid * 16 + i * 8192, R, C); va[0][i] = (unsigned)((u.pm * 256 + R) * K + C) * 2u; }
    }
};
struct SrcDense8 {
    const char* A; const char* Bt; int K;
    __device__ __forceinline__ const char* abase() const { return A; }
    __device__ __forceinline__ const char* bptr(const gm::Unit& u) const { return Bt + (size_t)u.pn * 256 * K; }
    static constexpr bool GATHER = false, FP8 = true;
    __device__ __forceinline__ void aoff(const gm::Unit& u, int tid, unsigned (&va)[1][2], int) const {
        asm volatile("" : "+v"(tid));
#pragma unroll
        for (int i = 0; i < 2; ++i) { int R, C; gm::stage_rc(tid * 16 + i * 8192, R, C); va[0][i] = (unsigned)((u.pm * 256 + R) * K + 2 * C); }
    }
};
struct SrcGateUp {
    const char* A; const char* Bt; const LAS int* ec; ETab T; int K;
    __device__ __forceinline__ const char* abase() const { return A; }
    __device__ __forceinline__ const char* bptr(const gm::Unit& u) const { const int e = T.pe[u.pm]; return Bt + ((size_t)e * 2048 + (size_t)u.pn * 256) * 2048; }
    static constexpr bool GATHER = true, FP8 = true;
    __device__ __forceinline__ void aoff(const gm::Unit& u, int tid, unsigned (&va)[2][2], int ui) const {
        asm volatile("" : "+v"(tid));
        const LAS int* ix = ec + (ui < EC_MAXU ? ui : EC_MAXU - 1) * 512;
#pragma unroll
        for (int i = 0; i < 2; ++i) { int R, C; gm::stage_rc(tid * 16 + i * 8192, R, C);
#pragma unroll
            for (int h = 0; h < 2; ++h) va[h][i] = (unsigned)(ix[h * 128 + R] * 2048 + 2 * C); }
    }
};
struct SrcDown {
    const char* A; const char* Bt; ETab T; int K;
    __device__ __forceinline__ const char* abase() const { return A; }
    __device__ __forceinline__ const char* bptr(const gm::Unit& u) const { const int e = T.pe[u.pm]; return Bt + ((size_t)e * 2048 + (size_t)u.pn * 256) * 1024; }
    static constexpr bool GATHER = false, FP8 = true;
    __device__ __forceinline__ void aoff(const gm::Unit& u, int tid, unsigned (&va)[1][2], int) const {
        asm volatile("" : "+v"(tid));
#pragma unroll
        for (int i = 0; i < 2; ++i) { int R, C; gm::stage_rc(tid * 16 + i * 8192, R, C); va[0][i] = (unsigned)((u.pm * 256 + R) * K + 2 * C); }
    }
};

#define EPI_BEGIN(ai, m) do { f32x4 _a0 = acc[ai][0][m][0], _a1 = acc[ai][0][m][1], _a2 = acc[ai][1][m][0], _a3 = acc[ai][1][m][1]; asm volatile("" : "+v"(_a0), "+v"(_a1), "+v"(_a2), "+v"(_a3)); A00 = _a0; A01 = _a1; A10 = _a2; A11 = _a3; } while (0)
#define EPI_END(x) asm volatile("" :: "v"(x) : "memory")
struct EpiInProj {
    bf16* PR; const LAS float* ec;
    __device__ __forceinline__ void operator()(const f32x4 (&acc)[2][2][4][2], const gm::Unit& u, int wr, int wc, int fr, int fq, int ui) const {
        const int pn = u.pn, lane = fq * 16 + fr;
        char* const ubase = (char*)PR + ((size_t)u.pm * 256 * DINM + 256 * pn) * 2;
        unsigned lo_qk = (unsigned)(((wr * 64 + fr) * DINM + 64 * wc + 16 * fq) * 2), lo_pl = (unsigned)(((wr * 64 + fr) * DINM + 32 * wc + 8 * fq) * 2);
        unsigned zz = 0, ro = (unsigned)((fr * 16 + 4 * fq) * 8), rq = (unsigned)(4 * fq * 8), nwo = (unsigned)(4 * fq * 4); asm volatile("" : "+v"(lo_qk), "+v"(lo_pl), "+v"(ro), "+v"(rq), "+v"(nwo), "+s"(zz));
        if (pn < 5) {
            const LAS char* nw = (const LAS char*)(ec + (pn < 4 ? 2048 : 2112));
            const float qs = pn < 4 ? 0.125f * LOG2E : 1.0f;
            const bool lat = u.pm < 64;
            f32x4 w[2][2];
#pragma unroll
            for (int bj = 0; bj < 2; ++bj)
#pragma unroll
                for (int n = 0; n < 2; ++n) w[bj][n] = *(const LAS f32x4*)(nw + nwo + (32 * bj + 16 * n) * 4);
#pragma unroll
            for (int ai = 0; ai < 2; ++ai) {
                f32x4 tr0, tr1, tc0[4], tc1[4];
                {
                    const int prow = (4 * u.pm + 2 * ai + wr) & 31;
                    const LAS float* rp = (const LAS float*)((const LAS char*)ec + prow * 128 + rq);
                    tr0 = *(const LAS f32x4*)rp; tr1 = *(const LAS f32x4*)(rp + 4);
                }
#pragma unroll
                for (int m = 0; m < 4; ++m) {
                    if ((m & 1) == 0) {
#pragma unroll
                        for (int mm = m; mm < m + 2; ++mm) { const LAS float* cp = (const LAS float*)((const LAS char*)ec + ro + mm * 2048); tc0[mm] = *(const LAS f32x4*)cp; tc1[mm] = *(const LAS f32x4*)(cp + 4); }
                    }
                    f32x4 y[2][2];
                    float ss = 0.f;
#pragma unroll
                    for (int bj = 0; bj < 2; ++bj)
#pragma unroll
                        for (int n = 0; n < 2; ++n) { const f32x4 v = acc[ai][bj][m][n] * W8I; y[bj][n] = v; ss += (v[0] * v[0] + v[1] * v[1]) + (v[2] * v[2] + v[3] * v[3]); }
                    ss += shx(ss, 16, lane); ss += shx(ss, 32, lane);
                    const float rstd = rsqrtf(ss * (1.0f / 64.0f) + EPS) * qs;
#pragma unroll
                    for (int bj = 0; bj < 2; ++bj)
#pragma unroll
                        for (int n = 0; n < 2; ++n) y[bj][n] = y[bj][n] * rstd * w[bj][n];
                    if (lat) {
#pragma unroll
                        for (int bj = 0; bj < 2; ++bj) {
                            const f32x4 t0 = bj ? tc0[m] : tr0, t1 = bj ? tc1[m] : tr1;
                            const f32x4 cs = (f32x4){t0[0], t0[2], t1[0], t1[2]}, sn = (f32x4){t0[1], t0[3], t1[1], t1[3]};
                            const f32x4 o0 = y[bj][0] * cs - y[bj][1] * sn, o1 = y[bj][1] * cs + y[bj][0] * sn;
                            y[bj][0] = o0; y[bj][1] = o1;
                        }
                    }
                    char* dst = ubase + (lo_qk + (unsigned)((ai * 128 + m * 16) * DINM * 2));
#pragma unroll
                    for (int bj = 0; bj < 2; ++bj) {
                        u32x4 pk; pk.x = cvt_pk_bf16(y[bj][0][0], y[bj][0][1]); pk.y = cvt_pk_bf16(y[bj][0][2], y[bj][0][3]); pk.z = cvt_pk_bf16(y[bj][1][0], y[bj][1][1]); pk.w = cvt_pk_bf16(y[bj][1][2], y[bj][1][3]);
                        *(u32x4*)(dst + 16 * bj) = pk;
                    }
                }
            }
        } else {
            const float sc = ((pn == 8 || pn == 9) ? 0.08838834764831845f : 1.0f) * W8I;
#pragma unroll
            for (int ai = 0; ai < 2; ++ai)
#pragma unroll
                for (int m = 0; m < 4; ++m) {
                    char* rowp = ubase + (lo_pl + (unsigned)((ai * 128 + m * 16) * DINM * 2));
#pragma unroll
                    for (int bj = 0; bj < 2; ++bj) {
                        const f32x4 v0 = acc[ai][bj][m][0] * sc, v1 = acc[ai][bj][m][1] * sc;
                        u32x4 pk; pk.x = cvt_pk_bf16(v0[0], v0[1]); pk.y = cvt_pk_bf16(v0[2], v0[3]); pk.z = cvt_pk_bf16(v1[0], v1[1]); pk.w = cvt_pk_bf16(v1[2], v1[3]);
                        *(u32x4*)(rowp + 256 * bj) = pk;
                    }
                }
        }
    }
};
struct EpiOutProj {
    const float* baseLat; const float* baseCtx; const bf16* baseB; bf16* outp; const float* g1; int wvi;
    __device__ __forceinline__ void operator()(const f32x4 (&acc)[2][2][4][2], const gm::Unit& u, int wr, int wc, int fr, int fq, int ui) const {
        const int pm = u.pm;
        const int mb = pm < 64 ? (pm >> 3) : 8;
        { const int l2 = otid(wvi) & 63; fr = l2 & 15; fq = l2 >> 4; }
        const int col0 = 256 * u.pn + 32 * wc + 8 * fq;
        char* const obase = (char*)outp + (size_t)pm * 256 * DM * 2;
        unsigned lo0 = (unsigned)((wr * 64 + fr) * DM + col0); unsigned zz = 0; asm volatile("" : "+v"(lo0), "+s"(zz));
        const float* gp = g1 + (size_t)mb * MODW + col0 + zz;
        f32x4 gv[2][2];
#pragma unroll
        for (int bj = 0; bj < 2; ++bj)
#pragma unroll
            for (int n = 0; n < 2; ++n) gv[bj][n] = *(const f32x4*)(gp + 128 * bj + 4 * n) * (W8I * C8I);
#pragma unroll
        for (int ai = 0; ai < 2; ++ai) {
            f32x4 bs[4][2][2];
            if (baseB) {
                const char* bb = (const char*)baseB + (size_t)pm * 256 * DM * 2;
#pragma unroll
                for (int m = 0; m < 4; ++m)
#pragma unroll
                    for (int bj = 0; bj < 2; ++bj) { const u32x4 w = *(const u32x4*)(bb + ((lo0 + (unsigned)((ai * 128 + m * 16) * DM) + 128 * bj) * 2));
                        bs[m][bj][0] = (f32x4){bflo(w.x), bfhi(w.x), bflo(w.y), bfhi(w.y)}; bs[m][bj][1] = (f32x4){bflo(w.z), bfhi(w.z), bflo(w.w), bfhi(w.w)}; }
            } else {
                const char* bf = (const char*)(pm < 64 ? baseLat + (size_t)pm * 256 * DM : baseCtx + (size_t)(pm - 64) * 256 * DM);
#pragma unroll
                for (int m = 0; m < 4; ++m)
#pragma unroll
                    for (int bj = 0; bj < 2; ++bj)
#pragma unroll
                        for (int n = 0; n < 2; ++n) bs[m][bj][n] = *(const f32x4*)(bf + ((lo0 + (unsigned)((ai * 128 + m * 16) * DM) + 128 * bj + 4 * n) * 4));
            }
#pragma unroll
            for (int m = 0; m < 4; ++m)
#pragma unroll
                for (int bj = 0; bj < 2; ++bj) {
                    const f32x4 o0 = bs[m][bj][0] + gv[bj][0] * acc[ai][bj][m][0], o1 = bs[m][bj][1] + gv[bj][1] * acc[ai][bj][m][1];
                    u32x4 pk; pk.x = cvt_pk_bf16(o0[0], o0[1]); pk.y = cvt_pk_bf16(o0[2], o0[3]); pk.z = cvt_pk_bf16(o1[0], o1[1]); pk.w = cvt_pk_bf16(o1[2], o1[3]);
                    *(u32x4*)(obase + ((lo0 + (unsigned)((ai * 128 + m * 16) * DM) + 128 * bj) * 2)) = pk;
                }
        }
    }
};
struct EpiGateUp {
    bf16* H; const LAS float* ec; ETab T;
    __device__ __forceinline__ void operator()(const f32x4 (&acc)[2][2][4][2], const gm::Unit& u, int wr, int wc, int fr, int fq, int ui) const {
        const int e = T.pe[u.pm], j0 = 128 * u.pn + 32 * wc + 8 * fq;
        char* const hbase = (char*)H + (size_t)u.pm * 256 * DFF;
        unsigned lo0 = (unsigned)((wr * 64 + fr) * DFF + j0); unsigned zz = 0; asm volatile("" : "+v"(lo0), "+s"(zz));
        const LAS float* bgp = ec + (ui < EC_MAXU ? ui : EC_MAXU - 1) * 512 + 256 + 32 * wc + 8 * fq;
        f32x4 bg[2], bu[2];
#pragma unroll
        for (int n = 0; n < 2; ++n) { bg[n] = *(const LAS f32x4*)(bgp + 4 * n); bu[n] = *(const LAS f32x4*)(bgp + 128 + 4 * n); }
#pragma unroll
        for (int ai = 0; ai < 2; ++ai)
#pragma unroll
            for (int m = 0; m < 4; ++m) {
                float hv[8];
#pragma unroll
                for (int n = 0; n < 2; ++n)
#pragma unroll
                    for (int i = 0; i < 4; ++i) {
                        const float gt = fminf(acc[ai][0][m][n][i] * W8I + bg[n][i], 7.0f);
                        const float up = fminf(fmaxf(acc[ai][1][m][n][i] * W8I + bu[n][i], -7.0f), 7.0f);
                        hv[4 * n + i] = (up + 1.0f) * gt * sigmoidf_(1.702f * gt);
                    }
                u32x2 pk; pk.x = pk4_fp8(hv[0], hv[1], hv[2], hv[3]); pk.y = pk4_fp8(hv[4], hv[5], hv[6], hv[7]);
                *(u32x2*)(hbase + (lo0 + (unsigned)((ai * 128 + m * 16) * DFF))) = pk;
            }
    }
};
struct EpiDown {
    bf16* Y; const LAS float* ec; ETab T;
    __device__ __forceinline__ void operator()(const f32x4 (&acc)[2][2][4][2], const gm::Unit& u, int wr, int wc, int fr, int fq, int ui) const {
        const int e = T.pe[u.pm], lp = u.pm - T.pbase[e], ne = T.cnt[e];
        const int col0 = 256 * u.pn + 64 * wc + 16 * fq;
        char* const ybase = (char*)Y + (size_t)u.pm * 256 * DM;
        unsigned lo0 = (unsigned)((wr * 64 + fr) * DM + col0); unsigned zz = 0; asm volatile("" : "+v"(lo0), "+s"(zz));
        const LAS float* ecu = ec + (ui < EC_MAXU ? ui : EC_MAXU - 1) * 512;
        f32x4 bv[2][2]; float wt[2][4];
#pragma unroll
        for (int bj = 0; bj < 2; ++bj)
#pragma unroll
            for (int n = 0; n < 2; ++n) bv[bj][n] = *(const LAS f32x4*)(ecu + 64 * wc + 16 * fq + 8 * bj + 4 * n);
#pragma unroll
        for (int ai = 0; ai < 2; ++ai)
#pragma unroll
            for (int m = 0; m < 4; ++m) wt[ai][m] = ecu[256 + ai * 128 + wr * 64 + m * 16 + fr];
#pragma unroll
        for (int ai = 0; ai < 2; ++ai)
#pragma unroll
            for (int m = 0; m < 4; ++m) {
                char* rowp = ybase + (lo0 + (unsigned)((ai * 128 + m * 16) * DM));
                const float ws_ = wt[ai][m] * Y8S;
                u32x4 pk;
                { const f32x4 v0 = (acc[ai][0][m][0] * W8I + bv[0][0]) * ws_, v1 = (acc[ai][0][m][1] * W8I + bv[0][1]) * ws_; pk.x = pk4_fp8(v0[0], v0[1], v0[2], v0[3]); pk.y = pk4_fp8(v1[0], v1[1], v1[2], v1[3]); }
                { const f32x4 v0 = (acc[ai][1][m][0] * W8I + bv[1][0]) * ws_, v1 = (acc[ai][1][m][1] * W8I + bv[1][1]) * ws_; pk.z = pk4_fp8(v0[0], v0[1], v0[2], v0[3]); pk.w = pk4_fp8(v1[0], v1[1], v1[2], v1[3]); }
                *(u32x4*)rowp = pk;
            }
    }
};

#define XB_TMO      128
#define XB_XCNT(j)  (256  + 64 * (j))
#define XB_XSUB(j)  (1280 + 64 * (j))
#define XB_XGEN(j)  (2304 + 64 * (j))
#define XB_TOP      3328
#define XB_TOPGEN   3392
#define XCD_BAR_WORDS 3456
#define XB_SPIN_CAP (1u << 24)
__device__ __forceinline__ unsigned xb_ld(unsigned* p)              { return __hip_atomic_load(p, __ATOMIC_RELAXED, __HIP_MEMORY_SCOPE_AGENT); }
__device__ __forceinline__ unsigned xb_add(unsigned* p, unsigned v) { return __hip_atomic_fetch_add(p, v, __ATOMIC_RELAXED, __HIP_MEMORY_SCOPE_AGENT); }
__device__ __forceinline__ unsigned xb_xcc_id() { return (unsigned)__builtin_amdgcn_s_getreg((3 << 11) | 20) & 0xFu; }
#define XB_SPIN(cond, bar) do { unsigned _sp = 0; while (cond) { __builtin_amdgcn_s_sleep(1); \
    if ((++_sp & 255u) == 0u) { if (xb_ld(&(bar)[XB_TMO])) break; if (_sp > XB_SPIN_CAP) { atomicAdd(&(bar)[XB_TMO], 1u); break; } } } } while (0)
struct XcdBarrier { unsigned* bar; unsigned x; volatile LAS unsigned* st; int wv; };
__device__ __forceinline__ XcdBarrier xcd_barrier_post(unsigned* bar, volatile LAS unsigned* st, int wv_) {
    XcdBarrier b; b.bar = bar; b.x = xb_xcc_id(); b.st = st; b.wv = wv_;
    if (otid(wv_) == 0) (void)xb_add(&bar[XB_XCNT(b.x)], 1u);
    return b;
}
__device__ __forceinline__ void xcd_barrier_complete(unsigned* bar, unsigned x, unsigned& nloc, unsigned& nx) {
    const unsigned G = gridDim.x * gridDim.y * gridDim.z;
    unsigned sum, cnt, mine, sp = 0u;
    for (;;) {
        sum = 0u; cnt = 0u; mine = 0u;
#pragma clang loop unroll(disable) vectorize(disable)
        for (unsigned j = 0; j < 16; ++j) { const unsigned c = xb_ld(&bar[XB_XCNT(j)]); sum += c; cnt += (c > 0u) ? 1u : 0u; mine = (j == x) ? c : mine; }
        if (sum == G) break;
        __builtin_amdgcn_s_sleep(1);
        if ((++sp & 255u) == 0u) { if (xb_ld(&bar[XB_TMO])) break; if (sp > XB_SPIN_CAP) { atomicAdd(&bar[XB_TMO], 1u); break; } }
    }
    nloc = mine > 0u ? mine : 1u; nx = cnt > 0u ? cnt : 1u;
}
__device__ __forceinline__ void xcd_barrier(const XcdBarrier& b) {
    const int wv_ = b.wv;
    asm volatile("s_waitcnt vmcnt(0)" ::: "memory");
    __syncthreads();
    if (otid(wv_) == 0) {
        unsigned* bar = b.bar; asm volatile("" : "+s"(bar));
        __builtin_amdgcn_s_waitcnt(0);
        unsigned nloc = b.st[0], nx = b.st[1];
        if (nloc == 0u) { xcd_barrier_complete(bar, b.x, nloc, nx); b.st[0] = nloc; b.st[1] = nx; }
        const unsigned old = xb_add(&bar[XB_XSUB(b.x)], 1u);
        const unsigned gen = old / nloc;
        if (old + 1u == (gen + 1u) * nloc) {
            __builtin_amdgcn_fence(__ATOMIC_RELEASE, "agent");
            asm volatile("s_waitcnt vmcnt(0)" ::: "memory");
            const unsigned og = xb_add(&bar[XB_TOP], 1u);
            const unsigned tg = og / nx;
            if (og + 1u == (tg + 1u) * nx) xb_add(&bar[XB_TOPGEN], 1u);
            else XB_SPIN(xb_ld(&bar[XB_TOPGEN]) == tg, bar);
            __builtin_amdgcn_fence(__ATOMIC_ACQUIRE, "agent");
            xb_add(&bar[XB_XGEN(b.x)], 1u);
            asm volatile("s_waitcnt vmcnt(0)" ::: "memory");
        } else {
            XB_SPIN(xb_ld(&bar[XB_XGEN(b.x)]) == gen, bar);
            __builtin_amdgcn_fence(__ATOMIC_ACQUIRE, "agent");
            asm volatile("s_waitcnt vmcnt(0)" ::: "memory");
        }
    }
    __syncthreads();
}

__device__ __forceinline__ void conv_item(const float* W, int ldw, int K, int k0, int src0, bf16* WT, size_t dstrow0, bool perm, LAS float* scr, int lane) {
    f32x4 v[8];
#pragma unroll
    for (int i = 0; i < 8; ++i) v[i] = *(const f32x4*)(W + (size_t)(k0 + (lane >> 3) + 8 * i) * ldw + src0 + 4 * (lane & 7));
#pragma unroll
    for (int i = 0; i < 8; ++i) { LAS float* s = scr + ((lane >> 3) + 8 * i) * 33 + 4 * (lane & 7); s[0] = v[i][0]; s[1] = v[i][1]; s[2] = v[i][2]; s[3] = v[i][3]; }
    LDS_WAIT(); asm volatile("" ::: "memory");
    const int c = lane & 7;
#pragma unroll
    for (int jj = 0; jj < 4; ++jj) {
        const int j = (lane >> 3) + 8 * jj, sc = perm ? gm::perm32(j) : j;
        const LAS float* s = scr + (8 * c) * 33 + sc;
        u32x4 o; o.x = pk2(s[0 * 33], s[1 * 33]); o.y = pk2(s[2 * 33], s[3 * 33]); o.z = pk2(s[4 * 33], s[5 * 33]); o.w = pk2(s[6 * 33], s[7 * 33]);
        *(u32x4*)(WT + (dstrow0 + j) * (size_t)K + k0 + 8 * c) = o;
    }
    LDS_WAIT(); asm volatile("" ::: "memory");
}

__device__ __forceinline__ void conv_item8(const float* W, int ldw, int K, int k0, int src0, unsigned char* WT8, size_t dstrow0, bool perm, LAS float* scr, int lane) {
    f32x4 v[8];
#pragma unroll
    for (int i = 0; i < 8; ++i) v[i] = *(const f32x4*)(W + (size_t)(k0 + (lane >> 3) + 8 * i) * ldw + src0 + 4 * (lane & 7));
#pragma unroll
    for (int i = 0; i < 8; ++i) { LAS float* s = scr + ((lane >> 3) + 8 * i) * 33 + 4 * (lane & 7); s[0] = v[i][0]; s[1] = v[i][1]; s[2] = v[i][2]; s[3] = v[i][3]; }
    LDS_WAIT(); asm volatile("" ::: "memory");
    const int j = lane >> 1, hf = lane & 1, sc = perm ? gm::perm32(j) : j;
    const LAS float* s = scr + (32 * hf) * 33 + sc;
    u32x4 o0, o1;
    o0.x = pk4_fp8(s[0 * 33] * W8S, s[1 * 33] * W8S, s[2 * 33] * W8S, s[3 * 33] * W8S);     o0.y = pk4_fp8(s[4 * 33] * W8S, s[5 * 33] * W8S, s[6 * 33] * W8S, s[7 * 33] * W8S);
    o0.z = pk4_fp8(s[8 * 33] * W8S, s[9 * 33] * W8S, s[10 * 33] * W8S, s[11 * 33] * W8S);   o0.w = pk4_fp8(s[12 * 33] * W8S, s[13 * 33] * W8S, s[14 * 33] * W8S, s[15 * 33] * W8S);
    o1.x = pk4_fp8(s[16 * 33] * W8S, s[17 * 33] * W8S, s[18 * 33] * W8S, s[19 * 33] * W8S); o1.y = pk4_fp8(s[20 * 33] * W8S, s[21 * 33] * W8S, s[22 * 33] * W8S, s[23 * 33] * W8S);
    o1.z = pk4_fp8(s[24 * 33] * W8S, s[25 * 33] * W8S, s[26 * 33] * W8S, s[27 * 33] * W8S); o1.w = pk4_fp8(s[28 * 33] * W8S, s[29 * 33] * W8S, s[30 * 33] * W8S, s[31 * 33] * W8S);
    unsigned char* d = WT8 + (dstrow0 + j) * (size_t)K + k0 + 32 * hf;
    *(u32x4*)d = o0; *(u32x4*)(d + 16) = o1;
    LDS_WAIT(); asm volatile("" ::: "memory");
}

struct CvItem { const float* src; unsigned char* dst; int ldw, K, k0; size_t dstrow0; bool perm, f8, p64; };
constexpr int CV_I_IN = 16 * 144, CV_I_OUT = 16 * 64, CV_I_GU = 16 * 64, CV_I_D = 8 * 64;
constexpr int CV_N_IN = DEPTH * CV_I_IN, CV_N_OUT = DEPTH * CV_I_OUT, CV_N_GU = DEPTH * NEXP * CV_I_GU, CV_N_D = DEPTH * NEXP * CV_I_D, CV_N_ALL = CV_N_IN + CV_N_OUT + CV_N_GU + CV_N_D;
constexpr int CV_NQ = CV_N_D / 2;
constexpr int CV_NPJ = CV_N_IN + CV_N_OUT;
constexpr int CV_NP = 0;
__device__ __forceinline__ int cv_pmap(int p) { return p; }
constexpr int CV_D0 = CV_N_IN + CV_N_OUT + CV_N_GU;
constexpr int CV_G0 = CV_N_IN + CV_N_OUT;
__device__ __forceinline__ int cv_qmap(int q) { return CV_N_IN + CV_N_OUT + CV_N_GU + CV_N_D / 2 + q; }
__device__ __forceinline__ CvItem cv_decode(LAS unsigned char* lds, int it) {
    unsigned char* ws = ((unsigned char*)AP(ws));
    CvItem d; d.p64 = false; int r = it;
    if (r < CV_N_IN) {
        const int l = r / CV_I_IN; r %= CV_I_IN; const int kb = r / 144, g = r % 144, pn = g >> 3, c0 = (g & 7) * 32;
        int src0; if (pn < 5) { const int bj = c0 >> 7, wc = (c0 >> 5) & 3; src0 = 256 * pn + 64 * wc + 32 * bj; d.perm = false; } else { src0 = 256 * pn + c0; d.perm = true; }
        d.src = AP(w_in) + (size_t)l * DM * DIN + src0; d.ldw = DIN; d.K = DM; d.k0 = kb * 128; d.dst = (unsigned char*)(ws + WS_WIN) + (size_t)l * DINM * DM; d.dstrow0 = (size_t)g * 32; d.f8 = true; return d;
    }
    r -= CV_N_IN;
    if (r < CV_N_OUT) {
        const int l = r / CV_I_OUT; r %= CV_I_OUT; const int kb = r / 64, g = r % 64;
        d.src = AP(w_out) + (size_t)l * DM * DM + g * 32; d.ldw = DM; d.K = DM; d.k0 = kb * 128; d.dst = (unsigned char*)(ws + WS_WOUT) + (size_t)l * DM * DM; d.dstrow0 = (size_t)g * 32; d.perm = true; d.f8 = true; return d;
    }
    r -= CV_N_OUT;
    if (r < CV_N_GU) {
        const int le = r / CV_I_GU; r %= CV_I_GU; const int kb = (r & 7) + 8 * (r >> 9), g = (r >> 3) & 63, pn = g >> 3,        c0 = (g & 7) * 32, bj = c0 >> 7, gg = (c0 >> 5) & 3;
        d.src = AP(w_gate_up) + (size_t)le * DM * 2048 + bj * 1024 + 128 * pn + 32 * gg; d.ldw = 2048; d.K = DM; d.k0 = kb * 128; d.dst = (unsigned char*)(ws + WS_WGU) + (size_t)le * 2048 * DM; d.dstrow0 = (size_t)g * 32; d.perm = true; d.f8 = true; return d;
    }
    r -= CV_N_GU;
    const int le = r / CV_I_D; r %= CV_I_D; const int kb = r & 7, g = r >> 3;
    d.src = AP(w_down) + (size_t)le * DFF * DM + (g >> 3) * 256 + 64 * (g & 3) + 8 * ((g >> 2) & 1); d.ldw = DM; d.K = DFF; d.k0 = kb * 128; d.dst = (unsigned char*)(ws + WS_WD) + (size_t)le * DM * DFF; d.dstrow0 = (size_t)g * 32; d.perm = true; d.f8 = true; d.p64 = true; return d;
}
__device__ __forceinline__ void cv_issue(const CvItem& d, f32x4 (&v)[16], int lane) {
    const int co = d.p64 ? 16 * ((lane & 7) >> 1) + 4 * (lane & 1) : 4 * (lane & 7);
#pragma unroll
    for (int i = 0; i < 16; ++i) if (i < 8 || d.f8) v[i] = __builtin_nontemporal_load((const f32x4*)(d.src + (size_t)(d.k0 + (lane >> 3) + 8 * i) * d.ldw + co));
}
__device__ __forceinline__ void cv_to_lds(const CvItem& d, const f32x4 (&v)[16], LAS float* scr, int lane) {
#pragma unroll
    for (int i = 0; i < 16; ++i) if (i < 8 || d.f8) { LAS float* sp = scr + ((lane >> 3) + 8 * i) * 33 + 4 * (lane & 7); sp[0] = v[i][0]; sp[1] = v[i][1]; sp[2] = v[i][2]; sp[3] = v[i][3]; }
    LDS_WAIT(); asm volatile("" ::: "memory");
}
__device__ __forceinline__ void cv_finish(const CvItem& d, LAS float* scr, int lane) {
    if (d.f8) {
        const int j = lane >> 1, hf = lane & 1, scn = d.perm ? gm::perm32(j) : j;
        const LAS float* sp = scr + (64 * hf) * 33 + scn;
        unsigned char* dp = d.dst + (d.dstrow0 + j) * (size_t)d.K + d.k0 + 64 * hf;
#pragma unroll
        for (int q = 0; q < 4; ++q) {
            u32x4 o;
            o.x = pk4_fp8(sp[(16 * q + 0) * 33] * W8S, sp[(16 * q + 1) * 33] * W8S, sp[(16 * q + 2) * 33] * W8S, sp[(16 * q + 3) * 33] * W8S);
            o.y = pk4_fp8(sp[(16 * q + 4) * 33] * W8S, sp[(16 * q + 5) * 33] * W8S, sp[(16 * q + 6) * 33] * W8S, sp[(16 * q + 7) * 33] * W8S);
            o.z = pk4_fp8(sp[(16 * q + 8) * 33] * W8S, sp[(16 * q + 9) * 33] * W8S, sp[(16 * q + 10) * 33] * W8S, sp[(16 * q + 11) * 33] * W8S);
            o.w = pk4_fp8(sp[(16 * q + 12) * 33] * W8S, sp[(16 * q + 13) * 33] * W8S, sp[(16 * q + 14) * 33] * W8S, sp[(16 * q + 15) * 33] * W8S);
            *(u32x4*)(dp + 16 * q) = o;
        }
    } else {
        const int c = lane & 7;
#pragma unroll
        for (int jj = 0; jj < 4; ++jj) {
            const int j = (lane >> 3) + 8 * jj, scn = d.perm ? gm::perm32(j) : j;
            const LAS float* sp = scr + (8 * c) * 33 + scn;
            u32x4 o; o.x = pk2(sp[0 * 33], sp[1 * 33]); o.y = pk2(sp[2 * 33], sp[3 * 33]); o.z = pk2(sp[4 * 33], sp[5 * 33]); o.w = pk2(sp[6 * 33], sp[7 * 33]);
            *(u32x4*)(d.dst + ((d.dstrow0 + j) * (size_t)d.K + d.k0 + 8 * c) * 2) = o;
        }
    }
    LDS_WAIT(); asm volatile("" ::: "memory");
}
#ifndef FS_CAP0
#define FS_CAP0 24
#define FS_CAP1 20
#define FS_CAP2 22
#define FS_CAP3 24
#endif
constexpr int CV_FW = 1;
constexpr int CW_PROG = 65536;
__device__ __forceinline__ int fs_rem(int s, int G) { const int n = s == 0 ? 72 * 18 : (s == 3 ? 64 * 18 + 64 : 576); return n % G; }
__device__ __forceinline__ int fs_cap(int s) { return s == 0 ? FS_CAP0 : s == 1 ? FS_CAP1 : s == 2 ? FS_CAP2 : FS_CAP3; }
__device__ __forceinline__ void fs_params(int s, int bx, int vcu, int G, int& rank, int& nidle, int& qb) {
    qb = 0;
    for (int j = 0; j < s; ++j) { const int r = fs_rem(j, G); qb += (r ? G - r : 0) * CV_FW * fs_cap(j); }
    const int r = fs_rem(s, G); nidle = r ? G - r : 0; rank = r ? (s == 1 ? vcu : bx) - r : -1;
}
__device__ __forceinline__ int fs_total(int G) { int q = 0; for (int j = 0; j < 4; ++j) { const int r = fs_rem(j, G); q += (r ? G - r : 0) * CV_FW * fs_cap(j); } return (G <= 256 && q <= CV_NQ) ? q : -1; }
__device__ __forceinline__ void conv_fill(LAS unsigned char* lds, int wv_, int s, int bx, int vcu, int G) {
    const int tid = otid(wv_), lane = tid & 63, wave = __builtin_amdgcn_readfirstlane(tid >> 6);
    unsigned* ctl = (unsigned*)(((unsigned char*)AP(ws)) + WS_CTL);
    unsigned* dn = ctl + CW_TD + 16 * s;
    __syncthreads();
    if (tid == 0) __hip_atomic_fetch_add(dn, 1u, __ATOMIC_RELAXED, __HIP_MEMORY_SCOPE_AGENT);
    int rank, nidle, qb; fs_params(s, bx, vcu, G, rank, nidle, qb);
    if (rank >= 0 && wave < CV_FW && fs_total(G) >= 0) {
        const int K = fs_cap(s), stride = nidle * CV_FW, q0 = qb + rank * CV_FW + wave;
        LAS float* scr = (LAS float*)(lds + wave * 17408);
        f32x4 va[16];
        int k = 0;
        unsigned dv = __hip_atomic_load(dn, __ATOMIC_RELAXED, __HIP_MEMORY_SCOPE_AGENT);
        if ((int)__builtin_amdgcn_readfirstlane(dv) < G) {
            CvItem da = cv_decode(lds, cv_qmap(q0)); cv_issue(da, va, lane);
#pragma clang loop unroll(disable)
            for (;;) {
                const CvItem d = da;
                cv_to_lds(d, va, scr, lane);
                dv = __hip_atomic_load(dn, __ATOMIC_RELAXED, __HIP_MEMORY_SCOPE_AGENT);
                const bool more = k + 1 < K;
                if (more) { da = cv_decode(lds, cv_qmap(q0 + (k + 1) * stride)); cv_issue(da, va, lane); }
                cv_finish(d, scr, lane);
                ++k;
                if (!more || (int)__builtin_amdgcn_readfirstlane(dv) >= G) break;
            }
        }
        if (lane == 0) __hip_atomic_store(ctl + CW_PROG + (s * 256 + bx) * 8 + wave, (unsigned)k, __ATOMIC_RELAXED, __HIP_MEMORY_SCOPE_AGENT);
    }
    __syncthreads();
}
__device__ __forceinline__ void conv_drain(LAS unsigned char* lds, int wv_, int bx, int vcu, int G) {
    const int tid = otid(wv_), lane = tid & 63, wave = __builtin_amdgcn_readfirstlane(tid >> 6);
    unsigned* ctl = (unsigned*)(((unsigned char*)AP(ws)) + WS_CTL);
    __syncthreads();
    LAS float* scr = (LAS float*)(lds + wave * 17408);
    f32x4 va[16];
    const int qt = fs_total(G);
    if (qt >= 0) {
        int pos = 0;
#pragma clang loop unroll(disable)
        for (int s = 0; s < 4; ++s) {
            int rank, nidle, qb; fs_params(s, bx, vcu, G, rank, nidle, qb);
            if (rank < 0) continue;
            const int K = fs_cap(s), stride = nidle * CV_FW;
#pragma clang loop unroll(disable)
            for (int w = 0; w < CV_FW; ++w) {
                const int k0 = (int)__builtin_amdgcn_readfirstlane(__hip_atomic_load(ctl + CW_PROG + (s * 256 + bx) * 8 + w, __ATOMIC_RELAXED, __HIP_MEMORY_SCOPE_AGENT));
#pragma clang loop unroll(disable)
                for (int k = k0; k < K; ++k, ++pos) {
                    if ((pos & 7) != wave) continue;
                    const CvItem d = cv_decode(lds, cv_qmap(qb + k * stride + rank * CV_FW + w));
                    cv_issue(d, va, lane); cv_to_lds(d, va, scr, lane); cv_finish(d, scr, lane);
                }
            }
        }
    }
    {
        const int NGW = G * 8, first = (qt >= 0 ? qt : 0) + vcu * 8 + wave;
        CvItem da = cv_decode(lds, cv_qmap(first < CV_NQ ? first : 0));
        if (first < CV_NQ) cv_issue(da, va, lane);
#pragma clang loop unroll(disable)
        for (int it = first; it < CV_NQ; it += NGW) {
            const CvItem d = da;
            cv_to_lds(d, va, scr, lane);
            if (it + NGW < CV_NQ) { da = cv_decode(lds, cv_qmap(it + NGW)); cv_issue(da, va, lane); }
            cv_finish(d, scr, lane);
        }
    }
    __syncthreads();
}

__device__ __forceinline__ void conv_static(LAS unsigned char* lds, int wv_, int base, int count, int vcu, int G) {
    const int tid = otid(wv_), lane = tid & 63, wave = __builtin_amdgcn_readfirstlane(tid >> 6);
    __syncthreads();
    LAS float* scr = (LAS float*)(lds + wave * 17408);
    f32x4 va[16], vb[16];
    const int NGW = G * 8, first = vcu * 8 + wave;
    CvItem da = cv_decode(lds, base + (first < count ? first : 0)), db = cv_decode(lds, base + (first + NGW < count ? first + NGW : 0));
    if (first < count) cv_issue(da, va, lane);
    if (first + NGW < count) cv_issue(db, vb, lane);
#pragma clang loop unroll(disable)
    for (int it = first; it < count; it += 2 * NGW) {
        {
            const CvItem d = da;
            cv_to_lds(d, va, scr, lane);
            if (it + 2 * NGW < count) { da = cv_decode(lds, base + it + 2 * NGW); cv_issue(da, va, lane); }
            cv_finish(d, scr, lane);
        }
        if (it + NGW < count) {
            const CvItem d = db;
            cv_to_lds(d, vb, scr, lane);
            if (it + 3 * NGW < count) { db = cv_decode(lds, base + it + 3 * NGW); cv_issue(db, vb, lane); }
            cv_finish(d, scr, lane);
        }
    }
    __syncthreads();
}

__device__ __forceinline__ void phase_prologue(LAS unsigned char* lds, int wv_, int vcu, int G) {
    const int tid = otid(wv_), lane = tid & 63, wave = __builtin_amdgcn_readfirstlane(tid >> 6);
    unsigned char* ws = ((unsigned char*)AP(ws));
    {
        const int gt = vcu * 512 + tid, NG = G * 512;
        float* rope = (float*)(ws + WS_ROPE);
        for (int it = gt; it < 64 * 16; it += NG) {
            const int pos = it >> 4, f = it & 15;
            double th = 1.0; for (int j = 0; j < f; ++j) th *= 0.5623413251903491;
            double s1 = 0.0, c1 = 0.0, term = 1.0;
            for (int n = 0; n < 24; ++n) { if ((n & 1) == 0) c1 += ((n >> 1) & 1) ? -term : term; else s1 += ((n >> 1) & 1) ? -term : term; term *= th / (double)(n + 1); }
            double cr = 1.0, sr = 0.0;
            for (int j = 0; j < pos; ++j) { const double nc = cr * c1 - sr * s1, ns = sr * c1 + cr * s1; cr = nc; sr = ns; }
            rope[it * 2] = (float)cr; rope[it * 2 + 1] = (float)sr;
        }
        float* wgp = (float*)(ws + WS_WGP);
        for (int it = gt; it < DEPTH * DM * 16; it += NG) {
            const int l = it / (DM * 16), r = it % (DM * 16), k = r >> 4, j = r & 15;
            const int s = k >> 5, g = (k >> 3) & 3, i = k & 7;
            wgp[(size_t)l * DM * 16 + ((s * 4 + g) * 16 + j) * 8 + i] = AP(w_in)[((size_t)l * DM + k) * DIN + DINM + j];
        }
        float* wrp = (float*)(ws + WS_WRP);
        for (int it = gt; it < DEPTH * DM * 32; it += NG) {
            const int l = it / (DM * 32), r = it % (DM * 32), k = r >> 5, jj = r & 31, tile = jj >> 4, j = jj & 15;
            const int s = k >> 5, g = (k >> 3) & 3, i = k & 7;
            wrp[(size_t)l * DM * 32 + (((s * 4 + g) * 2 + tile) * 16 + j) * 8 + i] = AP(w_router)[((size_t)l * DM + k) * NEXP + jj];
        }
    }
    {
        __syncthreads();
        LAS float* sc = (LAS float*)lds;
        LAS float* red = (LAS float*)(lds + 73728);
        bool staged = false;
        for (int it = vcu; it < 256; it += G) {
            if (!staged) {
                for (int i = tid; i < 9 * DM; i += 512) { const int r = i / DM, k = i % DM; const float v = r < 8 ? AP(c)[r * DM + k] : AP(c_ctx)[k]; sc[i] = v / (1.0f + __expf(-v)); }
                staged = true;
            }
            __syncthreads();
            const int l = it >> 7, cg = it & 127, lc = lane < 48 ? lane : 47, col = cg * 96 + 2 * lc;
            const float* W = AP(w_ada) + (size_t)l * DM * MODW + col;
            float acc[9][2];
#pragma unroll
            for (int r = 0; r < 9; ++r) { acc[r][0] = 0.f; acc[r][1] = 0.f; }
            for (int k16 = 0; k16 < 16; ++k16) {
                const int k = wave * 256 + k16 * 16;
                f32x2 w[16];
#pragma unroll
                for (int j = 0; j < 16; ++j) w[j] = *(const f32x2*)(W + (size_t)(k + j) * MODW);
#pragma unroll
                for (int r = 0; r < 9; ++r) {
#pragma unroll
                    for (int q = 0; q < 4; ++q) {
                        const f32x4 sv = *(const LAS f32x4*)(sc + r * DM + k + 4 * q);
#pragma unroll
                        for (int j = 0; j < 4; ++j) { acc[r][0] += sv[j] * w[4 * q + j][0]; acc[r][1] += sv[j] * w[4 * q + j][1]; }
                    }
                }
            }
            if (lane < 48) {
#pragma unroll
                for (int r = 0; r < 9; ++r) { red[(wave * 9 + r) * 96 + 2 * lane] = acc[r][0]; red[(wave * 9 + r) * 96 + 2 * lane + 1] = acc[r][1]; }
            }
            __syncthreads();
            for (int i = tid; i < 9 * 96; i += 512) {
                const int r = i / 96, cc = i % 96; float sum = 0.f;
#pragma unroll
                for (int w = 0; w < 8; ++w) sum += red[(w * 9 + r) * 96 + cc];
                ((float*)(ws + WS_MOD))[((size_t)l * 9 + r) * MODW + cg * 96 + cc] = sum + AP(b_ada)[(size_t)l * MODW + cg * 96 + cc];
            }
        }
        __syncthreads();
    }
    {
        LAS float* scr = (LAS float*)(lds + wave * 17408);
        const int gw = vcu * 8 + wave, NGW = G * 8;
        f32x4 va[16];
        CvItem da = cv_decode(lds, cv_pmap(gw < CV_NP ? gw : 0));
        if (gw < CV_NP) cv_issue(da, va, lane);
        for (int it = gw; it < CV_NP; it += NGW) {
            const CvItem d = da;
            cv_to_lds(d, va, scr, lane);
            if (it + NGW < CV_NP) { da = cv_decode(lds, cv_pmap(it + NGW)); cv_issue(da, va, lane); }
            cv_finish(d, scr, lane);
        }
    }
}

template <bool ROUTER, bool COMBINE, bool XBF  >
__device__ __forceinline__ void phase_norm(LAS unsigned char* lds, int wv_, int layer, int vcu, int G) {
    const int tid = otid(wv_), lane = tid & 63, wave = __builtin_amdgcn_readfirstlane(tid >> 6), r = lane & 15, g = lane >> 4;
    unsigned char* ws = ((unsigned char*)AP(ws));
    const float* MOD = (const float*)(ws + WS_MOD) + (size_t)layer * 9 * MODW;
    const float* nw = (ROUTER ? AP(norm2_w) : AP(norm1_w)) + (size_t)layer * DM;
    const int off_sh = ROUTER ? 3 * DM : 0, off_sc = ROUTER ? 4 * DM : DM;
    const int nrows = ROUTER ? (layer == 0 ? TT : TL) : TT;
    const int ngroups = nrows / 16;
    constexpr bool combine = COMBINE;
    LAS float* part0 = (LAS float*)(lds);
    LAS float* red0 = (LAS float*)(lds + 1024);
    LAS float* logit0 = (LAS float*)(lds + 1024 + 32768);
    LAS float* topv0 = logit0 + 1024;
    LAS int* topi0 = (LAS int*)(topv0 + 128);
    LAS int* ent_tok = (LAS int*)(lds + 49152);
    LAS int* ent_e = ent_tok + 1024; LAS int* ent_lp = ent_e + 1024; LAS float* ent_w = (LAS float*)(ent_lp + 1024);
    LAS int* lcount = (LAS int*)(ent_w + 1024); LAS int* lbase = lcount + 32; LAS int* nent = lbase + 32;
    ETab T; T.pe = nullptr; T.pbase = nullptr; T.cnt = nullptr;
    if (combine) T = build_etab(lds, wv_, (const unsigned*)(ws + WS_CTL) + CW_CNT);
    if (ROUTER) { if (tid < 32) lcount[tid] = 0; if (tid == 0) nent[0] = 0; }
    __syncthreads();
    const float* wpk = ROUTER ? (const float*)(ws + WS_WRP) + (size_t)layer * DM * 32 : (const float*)(ws + WS_WGP) + (size_t)layer * DM * 16;
    constexpr int NT = ROUTER ? 2 : 1;
    const int kb = wave * 256 + 8 * g;
    const float* xlat = AP(x); const float* xctx = AP(ctx);
    const bf16* xbb = (const bf16*)(ws + WS_XB);
    f32x4 xn[8][2]; u32x4 xr[8]; i32x4 ten = (i32x4){0, 0, 0, 0}, tpn = (i32x4){0, 0, 0, 0};
#define NORM_ISSUE(rg_) do { const int row_ = (rg_) * 16 + r; \
        if (XBF) { const bf16* sb_ = xbb + (size_t)row_ * DM + kb; _Pragma("unroll") for (int s = 0; s < 8; ++s) xr[s] = *(const u32x4*)(sb_ + 32 * s); } \
        else { const float* src_ = (row_ < TL ? xlat + (size_t)row_ * DM : xctx + (size_t)(row_ - TL) * DM) + kb; \
            _Pragma("unroll") for (int s = 0; s < 8; ++s) { xn[s][0] = *(const f32x4*)(src_ + 32 * s); xn[s][1] = *(const f32x4*)(src_ + 32 * s + 4); } } \
        if (combine) { ten = *(const i32x4*)((const int*)(ws + WS_TOKE) + (size_t)row_ * 4); tpn = *(const i32x4*)((const int*)(ws + WS_TOKP) + (size_t)row_ * 4); } } while (0)
    if (!COMBINE && vcu < ngroups) NORM_ISSUE(vcu);
    int par = 0;
    for (int rg = vcu; rg < ngroups; rg += G, par ^= 1) {
        LAS float* part = part0 + par * 128; LAS float* red = red0 + par * 4096; LAS float* logit = logit0 + par * 512;
        const int row = rg * 16 + r;
        const int mb = row < TL ? (row >> 11) : 8;
        if (COMBINE) NORM_ISSUE(rg);
        f32x4 xv[8][2];
#pragma unroll
        for (int s = 0; s < 8; ++s) {
            if (XBF) { xv[s][0] = (f32x4){bflo(xr[s].x), bfhi(xr[s].x), bflo(xr[s].y), bfhi(xr[s].y)}; xv[s][1] = (f32x4){bflo(xr[s].z), bfhi(xr[s].z), bflo(xr[s].w), bfhi(xr[s].w)}; }
            else { xv[s][0] = xn[s][0]; xv[s][1] = xn[s][1]; } }
        const i32x4 te = ten, tp = tpn;
        if (!COMBINE && rg + G < ngroups) NORM_ISSUE(rg + G);
        if (combine) {
            const float* g2 = (const float*)(ws + WS_MOD) + (size_t)mb * MODW + 5 * DM + kb;
            const unsigned char* Y = (const unsigned char*)(ws + WS_Y);
            bf16* xa = (bf16*)(ws + WS_XA) + (size_t)row * DM + kb;
            const unsigned char* y0 = Y + ((size_t)T.pbase[te[0]] * 256 + tp[0]) * DM + kb; const unsigned char* y1 = Y + ((size_t)T.pbase[te[1]] * 256 + tp[1]) * DM + kb;
            const unsigned char* y2 = Y + ((size_t)T.pbase[te[2]] * 256 + tp[2]) * DM + kb; const unsigned char* y3 = Y + ((size_t)T.pbase[te[3]] * 256 + tp[3]) * DM + kb;
            u32x2 ya[8], yb[8], yc[8], yd[8];
#pragma unroll
            for (int s = 0; s < 8; ++s) ya[s] = *(const u32x2*)(y0 + 32 * s);
#pragma unroll
            for (int s = 0; s < 8; ++s) yb[s] = *(const u32x2*)(y1 + 32 * s);
#pragma unroll
            for (int s = 0; s < 8; ++s) yc[s] = *(const u32x2*)(y2 + 32 * s);
#pragma unroll
            for (int s = 0; s < 8; ++s) yd[s] = *(const u32x2*)(y3 + 32 * s);
#pragma unroll
            for (int s = 0; s < 8; ++s) {
                const f32x4 s0 = ((up4_fp8(ya[s].x) + up4_fp8(yb[s].x)) + (up4_fp8(yc[s].x) + up4_fp8(yd[s].x))) * Y8I;
                const f32x4 s1 = ((up4_fp8(ya[s].y) + up4_fp8(yb[s].y)) + (up4_fp8(yc[s].y) + up4_fp8(yd[s].y))) * Y8I;
                xv[s][0] = xv[s][0] + *(const f32x4*)(g2 + 32 * s) * s0;
                xv[s][1] = xv[s][1] + *(const f32x4*)(g2 + 32 * s + 4) * s1;
                { u32x4 pk; pk.x = cvt_pk_bf16(xv[s][0][0], xv[s][0][1]); pk.y = cvt_pk_bf16(xv[s][0][2], xv[s][0][3]); pk.z = cvt_pk_bf16(xv[s][1][0], xv[s][1][1]); pk.w = cvt_pk_bf16(xv[s][1][2], xv[s][1][3]); *(u32x4*)(xa + 32 * s) = pk; }
            }
        }
        float ss = 0.f;
#pragma unroll
        for (int s = 0; s < 8; ++s)
#pragma unroll
            for (int h = 0; h < 2; ++h) ss += (xv[s][h][0] * xv[s][h][0] + xv[s][h][1] * xv[s][h][1]) + (xv[s][h][2] * xv[s][h][2] + xv[s][h][3] * xv[s][h][3]);
        ss += shx(ss, 16, lane); ss += shx(ss, 32, lane);
        if (g == 0) part[wave * 16 + r] = ss;
        __syncthreads();
        float tot = 0.f;
#pragma unroll
        for (int w = 0; w < 8; ++w) tot += part[w * 16 + r];
        const float rstd = rsqrtf(tot * (1.0f / DM) + EPS);
        const float* msh = MOD + (size_t)mb * MODW + off_sh + kb; const float* msc = MOD + (size_t)mb * MODW + off_sc + kb; const float* nwp = nw + kb;
#pragma unroll
        for (int s = 0; s < 8; ++s) {
#pragma unroll
            for (int h = 0; h < 2; ++h) {
                const f32x4 wv = *(const f32x4*)(nwp + 32 * s + 4 * h), scv = *(const f32x4*)(msc + 32 * s + 4 * h), shv = *(const f32x4*)(msh + 32 * s + 4 * h);
                xv[s][h] = xv[s][h] * rstd * wv * (scv + 1.0f) + shv;
            }
            { u32x2 pk; pk.x = pk4_fp8(xv[s][0][0], xv[s][0][1], xv[s][0][2], xv[s][0][3]); pk.y = pk4_fp8(xv[s][1][0], xv[s][1][1], xv[s][1][2], xv[s][1][3]);
                *(u32x2*)((unsigned char*)(ws + WS_HX) + (size_t)row * DM + kb + 32 * s) = pk; }
            if ((s & 1) == 1) asm volatile("" ::: "memory");
        }
        bf16x8 xh[8], xl[8];
#pragma unroll
        for (int s = 0; s < 8; ++s) {
            u32x4 hw, lw;
            hw.x = cvt_pk_bf16(xv[s][0][0], xv[s][0][1]); hw.y = cvt_pk_bf16(xv[s][0][2], xv[s][0][3]); hw.z = cvt_pk_bf16(xv[s][1][0], xv[s][1][1]); hw.w = cvt_pk_bf16(xv[s][1][2], xv[s][1][3]);
            lw.x = cvt_pk_bf16(xv[s][0][0] - bflo(hw.x), xv[s][0][1] - bfhi(hw.x)); lw.y = cvt_pk_bf16(xv[s][0][2] - bflo(hw.y), xv[s][0][3] - bfhi(hw.y));
            lw.z = cvt_pk_bf16(xv[s][1][0] - bflo(hw.z), xv[s][1][1] - bfhi(hw.z)); lw.w = cvt_pk_bf16(xv[s][1][2] - bflo(hw.w), xv[s][1][3] - bfhi(hw.w));
            xh[s] = __builtin_bit_cast(bf16x8, hw); xl[s] = __builtin_bit_cast(bf16x8, lw);
        }
        f32x4 acc[NT];
#pragma unroll
        for (int t = 0; t < NT; ++t) acc[t] = (f32x4){0.f, 0.f, 0.f, 0.f};
        {
            f32x4 bw[2][4][2];
#define NORM_BLOAD(buf_, b_) do { _Pragma("unroll") for (int s = 0; s < 4; ++s) { const float* bp = wpk + ((((size_t)(wave * 8 + 4 * ((b_) & 1) + s) * 4 + g) * NT + ((b_) >> 1)) * 16 + r) * 8; \
                bw[buf_][s][0] = *(const f32x4*)bp; bw[buf_][s][1] = *(const f32x4*)(bp + 4); } } while (0)
            NORM_BLOAD(0, 0);
#pragma unroll
            for (int bb = 0; bb < 2 * NT; ++bb) {
                const int t = bb >> 1, sh = bb & 1, cu = bb & 1;
                if (bb + 1 < 2 * NT) NORM_BLOAD(cu ^ 1, bb + 1);
#pragma unroll
                for (int s = 0; s < 4; ++s) {
                    u32x4 hw, lw;
                    hw.x = cvt_pk_bf16(bw[cu][s][0][0], bw[cu][s][0][1]); hw.y = cvt_pk_bf16(bw[cu][s][0][2], bw[cu][s][0][3]); hw.z = cvt_pk_bf16(bw[cu][s][1][0], bw[cu][s][1][1]); hw.w = cvt_pk_bf16(bw[cu][s][1][2], bw[cu][s][1][3]);
                    lw.x = cvt_pk_bf16(bw[cu][s][0][0] - bflo(hw.x), bw[cu][s][0][1] - bfhi(hw.x)); lw.y = cvt_pk_bf16(bw[cu][s][0][2] - bflo(hw.y), bw[cu][s][0][3] - bfhi(hw.y));
                    lw.z = cvt_pk_bf16(bw[cu][s][1][0] - bflo(hw.z), bw[cu][s][1][1] - bfhi(hw.z)); lw.w = cvt_pk_bf16(bw[cu][s][1][2] - bflo(hw.w), bw[cu][s][1][3] - bfhi(hw.w));
                    const bf16x8 wh = __builtin_bit_cast(bf16x8, hw), wl = __builtin_bit_cast(bf16x8, lw);
                    acc[t] = __builtin_amdgcn_mfma_f32_16x16x32_bf16(xl[4 * sh + s], wh, acc[t], 0, 0, 0);
                    acc[t] = __builtin_amdgcn_mfma_f32_16x16x32_bf16(xh[4 * sh + s], wl, acc[t], 0, 0, 0);
                    acc[t] = __builtin_amdgcn_mfma_f32_16x16x32_bf16(xh[4 * sh + s], wh, acc[t], 0, 0, 0);
                }
                asm volatile("" ::: "memory");
            }
#undef NORM_BLOAD
        }
#pragma unroll
        for (int t = 0; t < NT; ++t)
#pragma unroll
            for (int q = 0; q < 4; ++q) red[wave * 512 + (4 * g + q) * 32 + 16 * t + r] = acc[t][q];
        __syncthreads();
        if (!ROUTER) {
            if (tid < 256) {
                const int rr = tid >> 4, j = tid & 15; float v = 0.f;
#pragma unroll
                for (int w = 0; w < 8; ++w) v += red[w * 512 + rr * 32 + j];
                v += AP(b_gates)[layer * 16 + j];
                const float z = v * (1.0f / 15.0f);
                v = 15.0f * (1.0f - 2.0f / (__expf(2.0f * z) + 1.0f));
                ((float*)(ws + WS_GATES))[(size_t)(rg * 16 + rr) * 16 + j] = v;
            }
        } else {
            LAS float* topv = topv0 + par * 64; LAS int* topi = topi0 + par * 64;
            const int rr = tid >> 5, j = tid & 31; float v = 0.f;
#pragma unroll
            for (int w = 0; w < 8; ++w) v += red[w * 512 + rr * 32 + j];
            v += AP(b_router)[layer * NEXP + j];
            logit[rr * 32 + j] = v;
            __syncthreads();
            int rank = 0;
#pragma unroll 8
            for (int e = 0; e < NEXP; ++e) { const float o = logit[rr * 32 + e]; rank += (o > v || (o == v && e < j)) ? 1 : 0; }
            if (rank < 4) { topv[rr * 4 + rank] = v; topi[rr * 4 + rank] = j; }
            __syncthreads();
            if (tid < 64) {
                const int row2 = tid >> 2, k = tid & 3, tok = rg * 16 + row2;
                const float v0 = topv[row2 * 4 + 0], e1 = __expf(topv[row2 * 4 + 1] - v0), e2 = __expf(topv[row2 * 4 + 2] - v0), e3 = __expf(topv[row2 * 4 + 3] - v0);
                const float mine = __expf(topv[row2 * 4 + k] - v0), inv = 1.0f / (1.0f + e1 + e2 + e3);
                const int e = topi[row2 * 4 + k];
                const int base = atomicAdd((int*)nent, 1);
                const int lp = atomicAdd((int*)&lcount[e], 1);
                ent_tok[base] = tok * 4 + k; ent_e[base] = e; ent_lp[base] = lp; ent_w[base] = mine * inv;
            }
        }
    }
#undef NORM_ISSUE
    if (ROUTER) {
        __syncthreads();
        unsigned* gcnt = (unsigned*)(ws + WS_CTL) + CW_CNT + 32 * layer;
        if (tid < 32) lbase[tid] = (int)atomicAdd(&gcnt[tid], (unsigned)lcount[tid]);
        __syncthreads();
        const int n = nent[0];
        for (int i = tid; i < n; i += 512) {
            const int e = ent_e[i], pos = lbase[e] + ent_lp[i], tk = ent_tok[i];
            ((int*)(ws + WS_IDXL))[(size_t)e * TT + pos] = tk >> 2;
            ((float*)(ws + WS_WL))[(size_t)e * TT + pos] = ent_w[i];
            ((int*)(ws + WS_TOKE))[tk] = e; ((int*)(ws + WS_TOKP))[tk] = pos;
        }
    }
    __syncthreads();
}

typedef short v4i16_t __attribute__((ext_vector_type(4)));
__device__ __forceinline__ u32x2 trr(const LAS bf16* p) { return __builtin_bit_cast(u32x2, __builtin_amdgcn_ds_read_tr16_b64_v4i16((LAS v4i16_t*)p)); }
__device__ __forceinline__ bf16x8 cat8(u32x2 lo, u32x2 hi) { u32x4 w; w.x = lo.x; w.y = lo.y; w.z = hi.x; w.w = hi.y; return __builtin_bit_cast(bf16x8, w); }

__device__ __forceinline__ void attn_unit(LAS unsigned char* lds, int wv_, int layer, int b, int nblk, int half, int kvh) {
    const int tid = otid(wv_), lane = tid & 63, wave = __builtin_amdgcn_readfirstlane(tid >> 6), qi = lane & 15, gq = lane >> 4;
    unsigned char* ws = ((unsigned char*)AP(ws));
    const bf16* PR = (const bf16*)(ws + WS_PR);
    unsigned char* CAT = (unsigned char*)(ws + WS_CAT);
    LAS bf16* Lq = (LAS bf16*)(lds + 40960);
    const bool isctx = nblk < 0;
    const int qrow0 = isctx ? TL + b * CTXL + half * 128 : b * SEQ + nblk * 128;
    const int hq = kvh * 4 + (wave >> 1), qoff = (wave & 1) * 64;
    const int nloc = isctx ? 0 : 3 - (nblk == 0 ? 1 : 0) - (nblk == SEQ / 128 - 1 ? 1 : 0), j0 = (!isctx && nblk == 0) ? 1 : 0, ntile = nloc + 2;
#define T_ROW(ti_) ((ti_) < nloc ? b * SEQ + (nblk - 1 + j0 + (ti_)) * 128 : TL + b * CTXL + ((ti_) - nloc) * 128)
#define T_TL(ti_) ((ti_) < nloc ? j0 + (ti_) : 1)
    u32x4 rk[2], rv[2];
#define AT_LOAD(krow0_) do { _Pragma("unroll") for (int j = 0; j < 2; ++j) { const int cid = tid + 512 * j, key = cid >> 3, c = cid & 7; \
        rk[j] = *(const u32x4*)(PR + (size_t)((krow0_) + key) * DINM + 1024 + kvh * 64 + 8 * c); rv[j] = *(const u32x4*)(PR + (size_t)((krow0_) + key) * DINM + 1280 + kvh * 64 + 8 * c); } } while (0)
    AT_LOAD(T_ROW(0));
    __syncthreads();
#pragma unroll
    for (int j = 0; j < 8; ++j) {
        const int cid = tid + 512 * j, rowi = cid >> 3, c = cid & 7, hh = rowi >> 7, qr = rowi & 127;
        *(LAS u32x4*)(Lq + rowi * 72 + 8 * c) = *(const u32x4*)(PR + (size_t)(qrow0 + qr) * DINM + (kvh * 4 + hh) * 64 + 8 * c);
    }
    const float sinkv = AP(attn_sink)[layer * 16 + hq] * LOG2E;
    float mrun[4], lsum[4]; f32x4 o[4][4]; const f32x4 zq = zero4();
#pragma unroll
    for (int qt = 0; qt < 4; ++qt) { mrun[qt] = sinkv; lsum[qt] = 1.0f;
#pragma unroll
        for (int dt = 0; dt < 4; ++dt) o[qt][dt] = zq; }
#define AT_STAGE(set_) do { LAS bf16* Kw_ = (LAS bf16*)(lds + ((set_) ? 114688 : 0)); LAS bf16* Vw_ = Kw_ + 10240; \
        _Pragma("unroll") for (int j = 0; j < 2; ++j) { const int cid = tid + 512 * j, key = cid >> 3, c = cid & 7; *(LAS u32x4*)(Kw_ + key * 80 + 8 * c) = rk[j]; *(LAS u32x4*)(Vw_ + key * 80 + 8 * c) = rv[j]; } } while (0)
    AT_STAGE(0);
    if (ntile > 1) AT_LOAD(T_ROW(1));
    LDS_WAIT();
    __syncthreads();
#pragma unroll 1
    for (int ti = 0; ti < ntile; ++ti) {
        const int tl = T_TL(ti), cur = ti & 1;
        const LAS bf16* Kt = (const LAS bf16*)(lds + (cur ? 114688 : 0)); const LAS bf16* Vt = Kt + 10240;
        if (ti + 1 < ntile) { AT_STAGE(cur ^ 1); if (ti + 2 < ntile) AT_LOAD(T_ROW(ti + 2)); }
#pragma unroll
        for (int qp = 0; qp < 2; ++qp) {
            bf16x8 qb[2][2];
#pragma unroll
            for (int u = 0; u < 2; ++u)
#pragma unroll
                for (int kk = 0; kk < 2; ++kk) qb[u][kk] = *(const LAS bf16x8*)(Lq + ((wave >> 1) * 128 + qoff + 16 * (2 * qp + u) + qi) * 72 + 32 * kk + 8 * gq);
            f32x4 s[2][8];
            __builtin_amdgcn_s_setprio(1);
#pragma unroll
            for (int kt = 0; kt < 8; ++kt) {
                const bf16x8 ka0 = *(const LAS bf16x8*)(Kt + (16 * kt + qi) * 80 + 8 * gq), ka1 = *(const LAS bf16x8*)(Kt + (16 * kt + qi) * 80 + 32 + 8 * gq);
#pragma unroll
                for (int u = 0; u < 2; ++u) {
                    s[u][kt] = __builtin_amdgcn_mfma_f32_16x16x32_bf16(ka0, qb[u][0], (f32x4){0.f, 0.f, 0.f, 0.f}, 0, 0, 0);
                    s[u][kt] = __builtin_amdgcn_mfma_f32_16x16x32_bf16(ka1, qb[u][1], s[u][kt], 0, 0, 0);
                }
            }
            __builtin_amdgcn_s_setprio(0);
            if (tl != 1) {
                const int sgn = (tl == 0) ? 1 : -1;
#pragma unroll
                for (int u = 0; u < 2; ++u) {
                    const int dbase = 4 * gq - (qoff + 16 * (2 * qp + u) + qi);
#pragma unroll
                    for (int kt = 0; kt < 8; ++kt)
#pragma unroll
                        for (int rr = 0; rr < 4; ++rr) { const int d = sgn * (dbase + 16 * kt + rr); s[u][kt][rr] += __int_as_float((d >> 31) & (int)0xF149F2CAu); }
                }
            }
            float alpha[2];
#pragma unroll
            for (int u = 0; u < 2; ++u) {
                const int qt = 2 * qp + u;
                float mx = -1.0e30f;
#pragma unroll
                for (int kt = 0; kt < 8; ++kt) mx = fmaxf(fmaxf(mx, fmaxf(s[u][kt][0], s[u][kt][1])), fmaxf(s[u][kt][2], s[u][kt][3]));
                mx = fmaxf(mx, shx(mx, 16, lane)); mx = fmaxf(mx, shx(mx, 32, lane));
                const float mnew = fmaxf(mrun[qt], mx);
                alpha[u] = __builtin_amdgcn_exp2f(mrun[qt] - mnew);
                float rs = 0.f;
#pragma unroll
                for (int kt = 0; kt < 8; ++kt)
#pragma unroll
                    for (int rr = 0; rr < 4; ++rr) { const float p = __builtin_amdgcn_exp2f(s[u][kt][rr] - mnew); s[u][kt][rr] = p; rs += p; }
                rs += shx(rs, 16, lane); rs += shx(rs, 32, lane);
                lsum[qt] = lsum[qt] * alpha[u] + rs; mrun[qt] = mnew;
#pragma unroll
                for (int dt = 0; dt < 4; ++dt) o[qt][dt] = o[qt][dt] * alpha[u];
            }
            __builtin_amdgcn_s_setprio(1);
#pragma unroll
            for (int k2 = 0; k2 < 4; ++k2) {
                bf16x8 pb[2];
#pragma unroll
                for (int u = 0; u < 2; ++u) {
                    u32x4 pw; pw.x = cvt_pk_bf16(s[u][2 * k2][0], s[u][2 * k2][1]); pw.y = cvt_pk_bf16(s[u][2 * k2][2], s[u][2 * k2][3]); pw.z = cvt_pk_bf16(s[u][2 * k2 + 1][0], s[u][2 * k2 + 1][1]); pw.w = cvt_pk_bf16(s[u][2 * k2 + 1][2], s[u][2 * k2 + 1][3]);
                    pb[u] = __builtin_bit_cast(bf16x8, pw);
                }
#pragma unroll
                for (int dt = 0; dt < 4; ++dt) {
                    const LAS bf16* vp = Vt + (32 * k2 + 4 * gq + (qi >> 2)) * 80 + 16 * dt + 4 * (qi & 3);
                    const bf16x8 vf = cat8(trr(vp), trr(vp + 16 * 80));
                    o[2 * qp][dt] = __builtin_amdgcn_mfma_f32_16x16x32_bf16(vf, pb[0], o[2 * qp][dt], 0, 0, 0);
                    o[2 * qp + 1][dt] = __builtin_amdgcn_mfma_f32_16x16x32_bf16(vf, pb[1], o[2 * qp + 1][dt], 0, 0, 0);
                }
            }
            __builtin_amdgcn_s_setprio(0);
        }
        if (ti + 1 < ntile) { LDS_WAIT(); __syncthreads(); }
    }
#undef AT_STAGE
#undef AT_LOAD
#undef T_ROW
#undef T_TL
#pragma unroll
    for (int qt = 0; qt < 4; ++qt) {
        const float inv = 1.0f / lsum[qt];
        unsigned char* dst = CAT + (size_t)(qrow0 + qoff + 16 * qt + qi) * DM + hq * 64 + 4 * gq;
#pragma unroll
        for (int dt = 0; dt < 4; ++dt) { const f32x4 ov = o[qt][dt] * (inv * C8S); *(unsigned*)(dst + 16 * dt) = pk4_fp8(clamp8(ov[0]), clamp8(ov[1]), clamp8(ov[2]), clamp8(ov[3])); }
    }
}

__device__ __forceinline__ void mlstm_item(LAS unsigned char* lds, int wv_, int layer, int item) {
    const int tid = otid(wv_), lane = tid & 63, wave = __builtin_amdgcn_readfirstlane(tid >> 6), li = lane & 15, g = lane >> 4;
    const int vs = item & 3, dir = (item >> 2) & 1, h = (item >> 3) & 3, b = item >> 5;
    unsigned char* ws = ((unsigned char*)AP(ws));
    const bf16* PR = (const bf16*)(ws + WS_PR);
    const float* GATES = (const float*)(ws + WS_GATES);
    bf16* HO = (bf16*)(ws + (dir ? WS_HB : WS_HF));
    float* GS = (float*)(ws + WS_GS) + (size_t)item * 18 * 384;
    constexpr int P = 144, PV = 80, PC = 72;
    LAS bf16* Lq = (LAS bf16*)lds;
    LAS bf16* Lk = (LAS bf16*)(lds + 36864);
    LAS bf16* Lkw = (LAS bf16*)(lds + 73728);
    LAS bf16* Lv = (LAS bf16*)(lds + 110592);
    LAS bf16* LCt = (LAS bf16*)(lds + 131072);
    LAS float* A_b = (LAS float*)(lds + 149504);
    LAS float* A_a = A_b + 128; LAS float* A_cm = A_a + 128; LAS float* A_n = A_cm + 128;
    auto chunk_base = [&](int ci) -> int { return ci < 2 ? TL + b * CTXL + (dir == 0 ? ci : 1 - ci) * 128 : b * SEQ + (dir == 0 ? ci - 2 : 17 - ci) * 128; };
    __syncthreads();
    for (int ci = wave; ci < 18; ci += 8) {
        const int base = chunk_base(ci);
        float lsf[2], ig[2];
#pragma unroll
        for (int j = 0; j < 2; ++j) {
            const int tau = 2 * lane + j, row = base + (dir == 0 ? tau : 127 - tau);
            ig[j] = GATES[(size_t)row * 16 + dir * 8 + h]; const float fg = GATES[(size_t)row * 16 + dir * 8 + 4 + h];
            lsf[j] = fminf(fg, 0.f) - log1pf(__expf(-fabsf(fg)));
        }
        float sc = lsf[0] + lsf[1];
#pragma unroll
        for (int off = 1; off < 64; off <<= 1) { const float t = shup(sc, off, lane); if (lane >= off) sc += t; }
        const float b0 = (sc - (lsf[0] + lsf[1])) + lsf[0], b1 = b0 + lsf[1];
        const float a0 = ig[0] - b0, a1 = ig[1] - b1;
        float mm = fmaxf(a0, a1);
#pragma unroll
        for (int off = 1; off < 64; off <<= 1) { const float t = shup(mm, off, lane); if (lane >= off) mm = fmaxf(mm, t); }
        float mex = shup(mm, 1, lane); if (lane == 0) mex = -3.0e38f;
        const float c0 = fmaxf(mex, a0), c1 = fmaxf(c0, a1);
        float* gs = GS + ci * 384 + 2 * lane;
        *(f32x2*)(gs) = (f32x2){b0, b1}; *(f32x2*)(gs + 128) = (f32x2){a0, a1}; *(f32x2*)(gs + 256) = (f32x2){c0, c1};
    }
    if (tid < 128) A_n[tid] = 0.f;
    VM_WAIT();
    __syncthreads();
    u32x4 rq[4], rk[4], rv[2]; float rg = 0.f, r_bl, r_cl, ra[4];
#define ML_LOAD(ci_) do { const int base_ = chunk_base(ci_); \
        _Pragma("unroll") for (int j = 0; j < 4; ++j) { const int cid = tid + 512 * j, tau = cid >> 4, c = cid & 15; const size_t ro = (size_t)(base_ + (dir == 0 ? tau : 127 - tau)) * DINM; \
            rq[j] = *(const u32x4*)(PR + ro + 1536 + h * 128 + 8 * c); rk[j] = *(const u32x4*)(PR + ro + 2048 + h * 128 + 8 * c); } \
        _Pragma("unroll") for (int j = 0; j < 2; ++j) { const int cid = tid + 512 * j, tau = cid >> 3, c = cid & 7; const size_t ro = (size_t)(base_ + (dir == 0 ? tau : 127 - tau)) * DINM; \
            rv[j] = *(const u32x4*)(PR + ro + 2560 + h * 256 + vs * 64 + 8 * c); } \
        _Pragma("unroll") for (int j = 0; j < 4; ++j) ra[j] = GS[(ci_) * 384 + 128 + ((tid + 512 * j) >> 4)]; \
        if (tid < 384) rg = GS[(ci_) * 384 + tid]; r_bl = GS[(ci_) * 384 + 127]; r_cl = GS[(ci_) * 384 + 383]; } while (0)
    ML_LOAD(0);
    float m = 0.f, wcar_prev = 0.f, npart = 0.f;
    f32x4 Cacc[4]; const f32x4 zq = zero4();
#pragma unroll
    for (int vt = 0; vt < 4; ++vt) Cacc[vt] = zq;
    for (int ci = 0; ci < 18; ++ci) {
        const int base = chunk_base(ci);
        const float mprev = m, blast = r_bl, mnew = blast + fmaxf(mprev, r_cl), wcar = __expf(blast + mprev - mnew);
        __syncthreads();
        if (ci > 0 && g == 0) A_n[16 * wave + li] = wcar_prev * A_n[16 * wave + li] + npart;
        if (tid < 384) A_b[tid] = rg;
#pragma unroll
        for (int j = 0; j < 4; ++j) {
            const int cid = tid + 512 * j, tau = cid >> 4, c = cid & 15;
            *(LAS u32x4*)(Lq + tau * P + 8 * c) = rq[j];
            *(LAS u32x4*)(Lk + tau * P + 8 * c) = rk[j];
        }
#pragma unroll
        for (int j = 0; j < 2; ++j) { const int cid = tid + 512 * j, tau = cid >> 3, c = cid & 7; *(LAS u32x4*)(Lv + tau * PV + 8 * c) = rv[j]; }
#pragma unroll
        for (int vt = 0; vt < 4; ++vt) { u32x2 cw; cw.x = cvt_pk_bf16(Cacc[vt][0], Cacc[vt][1]); cw.y = cvt_pk_bf16(Cacc[vt][2], Cacc[vt][3]); *(LAS u32x2*)(LCt + (16 * wave + li) * PC + 16 * vt + 4 * g) = cw; }
#pragma unroll
        for (int j = 0; j < 4; ++j) {
            const int cid = tid + 512 * j, tau = cid >> 4, c = cid & 15;
            const float wsv = __expf(blast + ra[j] - mnew);
            const u32x4 kv = rk[j]; u32x4 kw;
            kw.x = cvt_pk_bf16(bflo(kv.x) * wsv, bfhi(kv.x) * wsv); kw.y = cvt_pk_bf16(bflo(kv.y) * wsv, bfhi(kv.y) * wsv); kw.z = cvt_pk_bf16(bflo(kv.z) * wsv, bfhi(kv.z) * wsv); kw.w = cvt_pk_bf16(bflo(kv.w) * wsv, bfhi(kv.w) * wsv);
            *(LAS u32x4*)(Lkw + tau * P + 8 * c) = kw;
        }
        if (ci + 1 < 18) ML_LOAD(ci + 1);
        LDS_WAIT();
        __syncthreads();
        bf16x8 qa[4];
#pragma unroll
        for (int kk = 0; kk < 4; ++kk) qa[kk] = *(const LAS bf16x8*)(Lq + (16 * wave + li) * P + 32 * kk + 8 * g);
        __builtin_amdgcn_s_setprio(1);
        f32x4 sT[8];
#pragma unroll
        for (int kk = 0; kk < 4; ++kk)
#pragma unroll
            for (int st = 0; st < 8; ++st) {
                const bf16x8 kb = *(const LAS bf16x8*)(Lk + (16 * st + li) * P + 32 * kk + 8 * g);
                sT[st] = __builtin_amdgcn_mfma_f32_16x16x32_bf16(kb, qa[kk], kk == 0 ? (f32x4){0.f, 0.f, 0.f, 0.f} : sT[st], 0, 0, 0);
            }
        f32x4 hT[4];
#pragma unroll
        for (int kk = 0; kk < 4; ++kk)
#pragma unroll
            for (int vt = 0; vt < 4; ++vt) {
                const LAS bf16* cp = LCt + (32 * kk + 8 * g + (li >> 2)) * PC + 16 * vt + 4 * (li & 3);
                hT[vt] = __builtin_amdgcn_mfma_f32_16x16x32_bf16(cat8(trr(cp), trr(cp + 4 * PC)), qa[kk], kk == 0 ? (f32x4){0.f, 0.f, 0.f, 0.f} : hT[vt], 0, 0, 0);
            }
        __builtin_amdgcn_s_setprio(0);
        float nq = 0.f;
#pragma unroll
        for (int kk = 0; kk < 4; ++kk) {
            const u32x4 qw = __builtin_bit_cast(u32x4, qa[kk]);
            const f32x4 n0 = *(const LAS f32x4*)(A_n + 32 * kk + 8 * g), n1 = *(const LAS f32x4*)(A_n + 32 * kk + 8 * g + 4);
            nq += bflo(qw.x) * n0[0] + bfhi(qw.x) * n0[1] + bflo(qw.y) * n0[2] + bfhi(qw.y) * n0[3] + bflo(qw.z) * n1[0] + bfhi(qw.z) * n1[1] + bflo(qw.w) * n1[2] + bfhi(qw.w) * n1[3];
        }
        nq += shx(nq, 16, lane); nq += shx(nq, 32, lane);
        const float bt = A_b[16 * wave + li], mtt = bt + fmaxf(mprev, A_cm[16 * wave + li]), wint = __expf(bt + mprev - mtt);
        float rs = 0.f;
        {
            const int dbase = 4 * g - li - 16 * wave;
            const float bm = bt - mtt;
#pragma unroll
            for (int st = 0; st < 8; ++st) {
                const f32x4 a4 = *(const LAS f32x4*)(A_a + 16 * st + 4 * g);
#pragma unroll
                for (int r = 0; r < 4; ++r) {
                    const float arg = (dbase + 16 * st + r <= 0) ? (bm + a4[r]) : -1.0e30f;
                    const float p = sT[st][r] * __expf(arg);
                    sT[st][r] = p; rs += p;
                }
            }
        }
        rs += shx(rs, 16, lane); rs += shx(rs, 32, lane);
        const float hden = 1.0f / fmaxf(fabsf(rs + wint * nq), __expf(-mtt));
#pragma unroll
        for (int vt = 0; vt < 4; ++vt) { hT[vt] = hT[vt] * wint; Cacc[vt] = Cacc[vt] * wcar; }
        {
            __builtin_amdgcn_s_setprio(1);
            bf16x8 kf[4];
#pragma unroll
            for (int kk = 0; kk < 4; ++kk) { const LAS bf16* kp = Lkw + (32 * kk + 4 * g + (li >> 2)) * P + 16 * wave + 4 * (li & 3); kf[kk] = cat8(trr(kp), trr(kp + 16 * P)); }
#pragma unroll
            for (int kk = 0; kk < 4; ++kk) {
                u32x4 pw; pw.x = cvt_pk_bf16(sT[2 * kk][0], sT[2 * kk][1]); pw.y = cvt_pk_bf16(sT[2 * kk][2], sT[2 * kk][3]); pw.z = cvt_pk_bf16(sT[2 * kk + 1][0], sT[2 * kk + 1][1]); pw.w = cvt_pk_bf16(sT[2 * kk + 1][2], sT[2 * kk + 1][3]);
                const bf16x8 pb = __builtin_bit_cast(bf16x8, pw);
#pragma unroll
                for (int vt = 0; vt < 4; ++vt) {
                    const LAS bf16* vp = Lv + (32 * kk + 4 * g + (li >> 2)) * PV + 16 * vt + 4 * (li & 3);
                    const bf16x8 vf = cat8(trr(vp), trr(vp + 16 * PV));
                    hT[vt] = __builtin_amdgcn_mfma_f32_16x16x32_bf16(vf, pb, hT[vt], 0, 0, 0);
                    Cacc[vt] = __builtin_amdgcn_mfma_f32_16x16x32_bf16(vf, kf[kk], Cacc[vt], 0, 0, 0);
                }
            }
            u32x4 on; on.x = 0x3f803f80u; on.y = 0x3f803f80u; on.z = 0x3f803f80u; on.w = 0x3f803f80u;
            f32x4 nacc = __builtin_amdgcn_mfma_f32_16x16x32_bf16(__builtin_bit_cast(bf16x8, on), kf[0], (f32x4){0.f, 0.f, 0.f, 0.f}, 0, 0, 0);
#pragma unroll
            for (int kk = 1; kk < 4; ++kk) nacc = __builtin_amdgcn_mfma_f32_16x16x32_bf16(__builtin_bit_cast(bf16x8, on), kf[kk], nacc, 0, 0, 0);
            npart = nacc[0];
            __builtin_amdgcn_s_setprio(0);
        }
        if (!(layer == 1 && ci < 2)) {
            LAS bf16* Hs = Lq + (16 * wave) * P;
#pragma unroll
            for (int vt = 0; vt < 4; ++vt) { u32x2 hw; hw.x = cvt_pk_bf16(hT[vt][0] * hden, hT[vt][1] * hden); hw.y = cvt_pk_bf16(hT[vt][2] * hden, hT[vt][3] * hden); *(LAS u32x2*)(Hs + li * P + 16 * vt + 4 * g) = hw; }
#pragma unroll
            for (int j = 0; j < 2; ++j) {
                const int cid = lane + 64 * j, tr = cid >> 3, c = cid & 7, t = 16 * wave + tr, row = base + (dir == 0 ? t : 127 - t);
                *(u32x4*)(HO + (size_t)row * 1024 + h * 256 + vs * 64 + 8 * c) = *(const LAS u32x4*)(Hs + tr * P + 8 * c);
            }
        }
        m = mnew; wcar_prev = wcar;
    }
#undef ML_LOAD
    __syncthreads();
}

__device__ __forceinline__ void phase_mlcomb(LAS unsigned char* lds, int wv_, int layer, int vcu, int G) {
    const int tid = otid(wv_), lane = tid & 63, wave = tid >> 6;
    const int nrows = layer == 0 ? TT : TL;
    unsigned char* ws = ((unsigned char*)AP(ws));
    const bf16* HF = (const bf16*)(ws + WS_HF); const bf16* HB = (const bf16*)(ws + WS_HB); const bf16* PR = (const bf16*)(ws + WS_PR);
    unsigned char* CAT = (unsigned char*)(ws + WS_CAT);
    const float* mnw = AP(mlstm_norm_w) + (size_t)layer * 1024;
    for (int it = vcu * 8 + wave; it < nrows * 4; it += G * 8) {
        const int row = it >> 2, h = it & 3, col = h * 256 + 4 * lane;
        const u32x2 f = *(const u32x2*)(HF + (size_t)row * 1024 + col), bb = *(const u32x2*)(HB + (size_t)row * 1024 + col), oo = *(const u32x2*)(PR + (size_t)row * DINM + 3584 + col);
        f32x4 s = (f32x4){bflo(f.x) + bflo(bb.x), bfhi(f.x) + bfhi(bb.x), bflo(f.y) + bflo(bb.y), bfhi(f.y) + bfhi(bb.y)};
        float ss = (s[0] * s[0] + s[1] * s[1]) + (s[2] * s[2] + s[3] * s[3]);
#pragma unroll
        for (int o = 1; o < 64; o <<= 1) ss += shx(ss, o, lane);
        const float rstd = rsqrtf(ss * (1.0f / 256.0f) + EPS);
        const f32x4 w = *(const f32x4*)(mnw + col);
        const f32x4 og = (f32x4){sigmoidf_(bflo(oo.x)), sigmoidf_(bfhi(oo.x)), sigmoidf_(bflo(oo.y)), sigmoidf_(bfhi(oo.y))};
        const f32x4 y = s * (rstd * C8S) * w * og;
        *(unsigned*)(CAT + (size_t)row * DM + 1024 + col) = pk4_fp8(clamp8(y[0]), clamp8(y[1]), clamp8(y[2]), clamp8(y[3]));
    }
}

__device__ __forceinline__ void phase_final(LAS unsigned char* lds, int wv_, int vcu, int G) {
    const int tid = otid(wv_), lane = tid & 63, wave = tid >> 6;
    unsigned char* ws = ((unsigned char*)AP(ws));
    const ETab T = build_etab(lds, wv_, (const unsigned*)(ws + WS_CTL) + CW_CNT + 32);
    const unsigned char* Y = (const unsigned char*)(ws + WS_Y);
    for (int row = vcu * 8 + wave; row < TL; row += G * 8) {
        const i32x4 te = *(const i32x4*)((const int*)(ws + WS_TOKE) + (size_t)row * 4), tp = *(const i32x4*)((const int*)(ws + WS_TOKP) + (size_t)row * 4);
        const float* g2 = (const float*)(ws + WS_MOD) + ((size_t)9 + (row >> 11)) * MODW + 5 * DM;
        size_t so[4];
#pragma unroll
        for (int k = 0; k < 4; ++k) so[k] = ((size_t)T.pbase[te[k]] * 256 + tp[k]) * DM;
        const bf16* xb = (const bf16*)(ws + WS_XB) + (size_t)row * DM;
        float* op = ((float*)AP(out)) + (size_t)row * DM;
#pragma unroll
        for (int j = 0; j < 8; ++j) {
            const int col = 4 * lane + 256 * j;
            f32x4 sum = zero4();
#pragma unroll
            for (int k = 0; k < 4; ++k) sum += up4_fp8(*(const unsigned*)(Y + so[k] + col));
            const u32x2 xw = *(const u32x2*)(xb + col);
            *(f32x4*)(op + col) = (f32x4){bflo(xw.x), bfhi(xw.x), bflo(xw.y), bfhi(xw.y)} + *(const f32x4*)(g2 + col) * (sum * Y8I);
        }
    }
}

constexpr int NPH = 18;
template <unsigned PMASK>
__global__ void __launch_bounds__(512, 2) fwd(Args a) {
    extern __shared__ __attribute__((aligned(16))) unsigned char lds_raw[];
    LAS unsigned char* lds = (LAS unsigned char*)lds_raw;
    const int wv_ = __builtin_amdgcn_readfirstlane((int)threadIdx.x >> 6);
    const int tid = otid(wv_);
    const int G = gridDim.x; const int bx = blockIdx.x;
    const int vcu = (G % 8 == 0) ? (bx % 8) * (G / 8) + bx / 8 : bx;
    volatile LAS unsigned* barw = (volatile LAS unsigned*)(lds + BARW_OFF);
    if (tid < 2) barw[tid] = 0u;
    if (tid == 64) {
        LAS unsigned long long* pt = (LAS unsigned long long*)(lds + PTAB_OFF);
        pt[SLOT_x] = (unsigned long long)a.x;
        pt[SLOT_c] = (unsigned long long)a.c;
        pt[SLOT_ctx] = (unsigned long long)a.ctx;
        pt[SLOT_c_ctx] = (unsigned long long)a.c_ctx;
        pt[SLOT_w_ada] = (unsigned long long)a.w_ada;
        pt[SLOT_b_ada] = (unsigned long long)a.b_ada;
        pt[SLOT_norm1_w] = (unsigned long long)a.norm1_w;
        pt[SLOT_norm2_w] = (unsigned long long)a.norm2_w;
        pt[SLOT_w_in] = (unsigned long long)a.w_in;
        pt[SLOT_b_gates] = (unsigned long long)a.b_gates;
        pt[SLOT_q_norm_w] = (unsigned long long)a.q_norm_w;
        pt[SLOT_k_norm_w] = (unsigned long long)a.k_norm_w;
        pt[SLOT_attn_sink] = (unsigned long long)a.attn_sink;
        pt[SLOT_mlstm_norm_w] = (unsigned long long)a.mlstm_norm_w;
        pt[SLOT_w_out] = (unsigned long long)a.w_out;
        pt[SLOT_w_router] = (unsigned long long)a.w_router;
        pt[SLOT_b_router] = (unsigned long long)a.b_router;
        pt[SLOT_w_gate_up] = (unsigned long long)a.w_gate_up;
        pt[SLOT_b_gate_up] = (unsigned long long)a.b_gate_up;
        pt[SLOT_w_down] = (unsigned long long)a.w_down;
        pt[SLOT_b_down] = (unsigned long long)a.b_down;
        pt[SLOT_out] = (unsigned long long)a.out;
        pt[SLOT_ws] = (unsigned long long)a.ws;
    }
    __syncthreads();
    unsigned char* ws0 = (unsigned char*)AP(ws);
    XcdBarrier bar; bar.bar = (unsigned*)(ws0 + WS_CTL) + CW_BAR; bar.x = 0; bar.st = barw; bar.wv = wv_;
    const bool multi = (a.ph_hi - a.ph_lo) > 1;
    if (multi) bar = xcd_barrier_post((unsigned*)(ws0 + WS_CTL) + CW_BAR, barw, wv_);
    const int lo = a.ph_lo, hi = a.ph_hi;
#define PH_MASK PMASK
#define IN(k) (lo <= (k) && (k) < hi)
#define INL(j) (((PH_MASK >> ((j) + 1)) & 1) && IN(pb + (j)))
#define SEAM(k) do { if (IN(k) && IN((k) + 1)) xcd_barrier(bar); } while (0)
#define REP(t) for (int rep_ = 0; rep_ < (((DUP_MASK >> (t)) & 1u) ? 2 : 1); ++rep_, (rep_ < (((DUP_MASK >> (t)) & 1u) ? 2 : 1) && multi) ? xcd_barrier(bar) : (void)0)
    if ((PH_MASK & 1) && IN(0)) { REP(0) phase_prologue(lds, wv_, opqi(vcu), opqi(G)); }
    SEAM(0);
#pragma unroll
    for (int layer = 0; layer < DEPTH; ++layer) {
        const int pb = 1 + 8 * layer;
        const int Mrows = layer == 0 ? TT : TL;
        if (INL(0)) {
            if (layer == 0) {
                const int first = opqi(vcu) & 1;
#pragma clang loop unroll(disable)
                for (int stg = 0; stg < 2; ++stg) {
                    if ((stg ^ first) == 0) phase_norm<false, false, false>(lds, wv_, layer, opqi(vcu), opqi(G));
                    else {
                        const int vc = opqi(vcu), Gc = opqi(G);
                        if (Gc == 256) { conv_static(lds, wv_, 0, CV_NPJ - 2048, vc, Gc); if (vc >= 128) conv_static(lds, wv_, CV_NPJ - 2048, 2048, vc - 128, 128); }
                        else conv_static(lds, wv_, 0, CV_NPJ, vc, Gc);
                    }
                }
            } else phase_norm<false, true, true>(lds, wv_, layer, opqi(vcu), opqi(G));
        }
        SEAM(pb + 0);
        if (INL(1)) REP(2) {
            unsigned char* ws = ((unsigned char*)AP(ws));
            SrcDense8 S; S.A = (const char*)(ws + WS_HX); S.Bt = (const char*)(ws + WS_WIN) + (size_t)layer * DINM * DM; S.K = DM;
            gm::InProjOrder O; O.init(opqi(G), opqi(bx), layer == 0 ? 1 : 0);
            LAS float* ec = (LAS float*)(lds + EC_OFF);
            { const int tid = otid(wv_); __syncthreads();
              for (int i = tid; i < 2176; i += 512) ec[i] = i < 2048 ? ((const float*)(ws + WS_ROPE))[i] : (i < 2112 ? AP(q_norm_w)[layer * 64 + i - 2048] : AP(k_norm_w)[layer * 64 + i - 2112]);
              __syncthreads(); }
            EpiInProj E; E.PR = (bf16*)(ws + WS_PR); E.ec = ec;
            gm::gemm_phase(lds, wv_, S, O, E);
            conv_fill(lds, wv_, layer == 0 ? 0 : 3, opqi(bx), opqi(vcu), opqi(G));
        }
        SEAM(pb + 1);
        if (INL(2)) REP(3) {
            const int grp = opqi(vcu) & 3;
#pragma clang loop unroll(disable)
            for (int stg = 0; stg < 3; ++stg) {
                const int what = grp == 0 ? stg : (grp == 1 ? (stg == 0 ? 1 : (stg == 1 ? 0 : 2)) : (grp == 2 ? (stg == 0 ? 2 : (stg == 1 ? 0 : 1)) : 2 - stg));
                if (what == 0) conv_static(lds, wv_, CV_G0 + layer * (CV_N_GU / 2), CV_N_GU / 2, opqi(vcu), opqi(G));
                else if (what == 1) {
                    for (int it = opqi(vcu), Gm = opqi(G); it < 256; it += Gm) mlstm_item(lds, wv_, layer, it);
                } else {
                    const int nlat = NB * 16 * 4, nctx = layer == 0 ? NB * 2 * 4 : 0;
                    for (int it = opqi(vcu), Ga = opqi(G); it < nlat + nctx; it += Ga) {
                        int ab, an, ah, ag;
                        if (it < nlat) { ab = it >> 6; an = (it >> 2) & 15; ah = 0; ag = it & 3; }
                        else { const int j = it - nlat; ab = j >> 3; an = -1; ah = (j >> 2) & 1; ag = j & 3; }
                        attn_unit(lds, wv_, layer, ab, an, ah, ag);
                    }
                }
            }
            if (layer == 0) conv_fill(lds, wv_, 1, opqi(bx), opqi(vcu), opqi(G));
        }
        SEAM(pb + 2);
        if (INL(3)) { REP(4) phase_mlcomb(lds, wv_, layer, opqi(vcu), opqi(G)); }
        SEAM(pb + 3);
        if (INL(4)) REP(5) {
            unsigned char* ws = ((unsigned char*)AP(ws));
            SrcDense8 S; S.A = (const char*)(ws + WS_CAT); S.Bt = (const char*)(ws + WS_WOUT) + (size_t)layer * DM * DM; S.K = DM;
            gm::StaticOrder O; O.init(Mrows / 256, DM / 256, opqi(G), opqi(bx));
            EpiOutProj E; E.baseLat = AP(x); E.baseCtx = AP(ctx); E.baseB = layer == 0 ? (const bf16*)nullptr : (const bf16*)(ws + WS_XA);
            E.outp = (bf16*)(ws + WS_XB); E.g1 = (const float*)(ws + WS_MOD) + (size_t)layer * 9 * MODW + 2 * DM; E.wvi = wv_;
            gm::gemm_phase(lds, wv_, S, O, E);
            if (layer == 0) conv_fill(lds, wv_, 2, opqi(bx), opqi(vcu), opqi(G));
        }
        SEAM(pb + 4);
        if (INL(5)) {
            if (layer != DEPTH - 1) {
                const int first = opqi(vcu) & 1;
#pragma clang loop unroll(disable)
                for (int stg = 0; stg < 2; ++stg) {
                    if ((stg ^ first) == 0) phase_norm<true, false, true>(lds, wv_, layer, opqi(vcu), opqi(G));
                    else if (layer == 0) {
                        const int vc = opqi(vcu), Gc = opqi(G);
                        if (Gc == 256) { conv_static(lds, wv_, CV_D0, CV_N_D / 2 - 2048, vc, Gc); if (vc >= 128) conv_static(lds, wv_, CV_D0 + CV_N_D / 2 - 2048, 2048, vc - 128, 128); }
                        else conv_static(lds, wv_, CV_D0, CV_N_D / 2, vc, Gc);
                    }
                }
            } else {
                const int first = opqi(vcu) & 1;
#pragma clang loop unroll(disable)
                for (int stg = 0; stg < 2; ++stg) {
                    if ((stg ^ first) == 0) phase_norm<true, false, true>(lds, wv_, layer, opqi(vcu), opqi(G));
                    else conv_drain(lds, wv_, opqi(bx), opqi(vcu), opqi(G));
                }
            }
        }
        SEAM(pb + 5);
        if (INL(6)) REP(7) {
            unsigned char* ws = ((unsigned char*)AP(ws));
            const ETab T = build_etab(lds, wv_, (const unsigned*)(ws + WS_CTL) + CW_CNT + 32 * layer);
            LAS int* ec = (LAS int*)(lds + EC_OFF);
            SrcGateUp S; S.A = (const char*)(ws + WS_HX); S.Bt = (const char*)(ws + WS_WGU) + (size_t)layer * NEXP * 2048 * DM; S.ec = ec; S.T = T; S.K = DM;
            gm::StaticOrder O; O.init(T.pbase[NEXP], 8, opqi(G), opqi(bx));
            { const int* idxl = (const int*)(ws + WS_IDXL); const float* bgu = AP(b_gate_up) + (size_t)layer * NEXP * 2048;
              ec_preload(wv_, O, [&](int i, const gm::Unit& u, int tid) {
                  const int e = T.pe[u.pm], lp = u.pm - T.pbase[e], ne = T.cnt[e];
                  if (tid < 256) { const int li = lp * 256 + tid; ec[i * 512 + tid] = li < ne ? idxl[(size_t)e * TT + li] : 0; }
                  else { const int t = tid - 256; ((LAS float*)ec)[i * 512 + 256 + t] = bgu[(size_t)e * 2048 + (t >> 7) * 1024 + 128 * u.pn + (t & 127)]; } }); }
            EpiGateUp E; E.H = (bf16*)(ws + WS_H); E.ec = (const LAS float*)ec; E.T = T;
            gm::gemm_phase(lds, wv_, S, O, E);
        }
        SEAM(pb + 6);
        if (INL(7)) REP(8) {
            unsigned char* ws = ((unsigned char*)AP(ws));
            const ETab T = build_etab(lds, wv_, (const unsigned*)(ws + WS_CTL) + CW_CNT + 32 * layer);
            SrcDown S; S.A = (const char*)(ws + WS_H); S.Bt = (const char*)(ws + WS_WD) + (size_t)layer * NEXP * DM * DFF; S.T = T; S.K = DFF;
            gm::StaticOrder O; O.init(T.pbase[NEXP], 8, opqi(G), opqi(bx));
            LAS float* ec = (LAS float*)(lds + EC_OFF);
            { const float* bd = AP(b_down) + (size_t)layer * NEXP * DM; const float* WL = (const float*)(ws + WS_WL);
              ec_preload(wv_, O, [&](int i, const gm::Unit& u, int tid) {
                  const int e = T.pe[u.pm], lp = u.pm - T.pbase[e], ne = T.cnt[e];
                  if (tid < 256) ec[i * 512 + tid] = bd[(size_t)e * DM + 256 * u.pn + tid];
                  else { const int li = lp * 256 + tid - 256; ec[i * 512 + tid] = li < ne ? WL[(size_t)e * TT + li] : 0.0f; } }); }
            EpiDown E; E.Y = (bf16*)(ws + WS_Y); E.ec = ec; E.T = T;
            gm::gemm_phase(lds, wv_, S, O, E);
        }
        SEAM(pb + 7);
    }
    if (((PH_MASK >> 17) & 1) && IN(17)) { REP(17) phase_final(lds, wv_, opqi(vcu), opqi(G)); }
#undef IN
#undef INL
#undef SEAM
#undef REP
#undef PH_MASK
}

typedef void (*kern_t)(Args);
#if MK_ONE_LAUNCH
static kern_t g_kern[1] = { fwd<0x3ffffu> };
#else
static kern_t g_kern[10] = { fwd<1u << 0>, fwd<1u << 1>, fwd<1u << 2>, fwd<1u << 3>, fwd<1u << 4>, fwd<1u << 5>, fwd<1u << 6>, fwd<1u << 7>, fwd<1u << 8>, fwd<1u << 17> };
#endif
extern "C" void kernel_launch(void* const* d_in, const int* in_sizes, int n_in, void* d_out, int out_size, void* d_ws, size_t ws_size, hipStream_t stream) {
    static int grid = 0;
    constexpr int NK = (int)(sizeof(g_kern) / sizeof(g_kern[0]));
    if (grid == 0) {
        if (n_in != 21 || out_size != TL * DM || ws_size < WS_END) { fprintf(stderr, "kernel_launch: unexpected problem (n_in %d, out %d, ws %zu)\n", n_in, out_size, ws_size); grid = -1; return; }
        int dev = 0, cus = 0;
        if (hipGetDevice(&dev) != hipSuccess || hipDeviceGetAttribute(&cus, hipDeviceAttributeMultiprocessorCount, dev) != hipSuccess) { grid = -1; return; }
        for (int k = 0; k < NK; ++k)
            if (hipFuncSetAttribute((const void*)g_kern[k], hipFuncAttributeMaxDynamicSharedMemorySize, LDS_BYTES) != hipSuccess) { fprintf(stderr, "kernel_launch: hipFuncSetAttribute failed\n"); grid = -1; return; }
        int per_cu = 0;
        if (hipOccupancyMaxActiveBlocksPerMultiprocessor(&per_cu, (const void*)g_kern[0], 512, LDS_BYTES) != hipSuccess || per_cu < 1) { fprintf(stderr, "kernel_launch: occupancy query says %d\n", per_cu); }
        (void)hipGetLastError();
        grid = cus;
    }
    if (grid < 0) return;
    (void)hipMemsetAsync((char*)d_ws + WS_CTL, 0, CTL_BYTES, stream);
    Args a{};
    const float** p = (const float**)&a;
    for (int i = 0; i < 21; ++i) p[i] = (const float*)d_in[i];
    a.out = (float*)d_out; a.ws = (unsigned char*)d_ws;
#if MK_ONE_LAUNCH
    a.ph_lo = 0; a.ph_hi = NPH;
    hipLaunchKernelGGL(g_kern[0], dim3(grid), dim3(512), LDS_BYTES, stream, a);
#else
    for (int ph = 0; ph < NPH; ++ph) {
        a.ph_lo = ph; a.ph_hi = ph + 1;
        const int t = ph == 0 ? 0 : (ph == NPH - 1 ? 9 : (ph - 1) % 8 + 1);
        hipLaunchKernelGGL(g_kern[t], dim3(grid), dim3(512), LDS_BYTES, stream, a);
    }
#endif
}
```
